# Optimizing an MI355X kernel written in HIP

```python
import jax, jax.numpy as jnp
from jax import lax
import numpy as np

D_MODEL = 1024
BATCH = 8
SEQ = 4096
DEPTH = 2
DEC_BATCH = 16
DEC_SEQ = 16
PAST_LEN = 2048

CHUNK = 64
D_CONV = 512
N_CONV_HEADS = 8
CONV_WIDTH = 3
D_POOL = 512
POOL_WINDOWS = (2, 4, 8, 16)
N_POOL_GROUPS = len(POOL_WINDOWS)
POOL_GROUP = D_POOL // N_POOL_GROUPS
POOL_STATE = max(POOL_WINDOWS) - 1
D_MIX = D_CONV + D_POOL
D_IN = 3 * D_CONV + D_POOL
D_FF = 2816
N_MEM = 256
N_XHEADS = 4
XHEAD_DIM = D_MODEL // N_XHEADS
EPS = 1e-6

kernel_name = "hybrid_conv_pool_streaming_encoder_step"


def rms_norm(x, g):
    xf = x.astype(jnp.float32)
    y = xf * lax.rsqrt(jnp.mean(xf * xf, axis=-1, keepdims=True) + EPS)
    return (y * g.astype(jnp.float32)).astype(x.dtype)


def swiglu_ffn(h, w_in, w_out):
    g, u = jnp.split(h @ w_in, 2, axis=-1)
    return (jax.nn.silu(g) * u) @ w_out


def short_conv(u, prefix, w):
    L = u.shape[1]
    full = jnp.concatenate([prefix.astype(u.dtype), u], axis=1)
    y = w[0] * full[:, 0:L]
    for k in range(1, CONV_WIDTH):
        y = y + w[k] * full[:, k:k + L]
    return y, full[:, -(CONV_WIDTH - 1):]


def multi_scale_pool(p, prefix, pos0):
    bsz, L, c = p.shape
    full = jnp.concatenate([prefix.astype(p.dtype), p], axis=1)
    cs = jnp.concatenate([jnp.zeros((bsz, 1, c), jnp.float32),
                          jnp.cumsum(full.astype(jnp.float32), axis=1)], axis=1)
    end = cs[:, POOL_STATE + 1:]
    pos = pos0 + jnp.arange(L)
    outs = []
    for g, w in enumerate(POOL_WINDOWS):
        sl = slice(g * POOL_GROUP, (g + 1) * POOL_GROUP)
        start = cs[:, POOL_STATE + 1 - w:POOL_STATE + 1 - w + L, sl]
        cnt = jnp.minimum(pos + 1, w).astype(jnp.float32)[None, :, None]
        outs.append((end[..., sl] - start) / cnt)
    mean = jnp.concatenate(outs, axis=-1)
    pooled = (mean - p.astype(jnp.float32)).astype(p.dtype)
    return pooled, full[:, -POOL_STATE:]


def token_mix(h, conv_prefix, pool_prefix, pos0, w_in, conv_w, pool_w, pool_scale, w_out):
    bsz, L, _ = h.shape
    z = h @ w_in
    b_gate, c_gate, v, p = jnp.split(z, [D_CONV, 2 * D_CONV, 3 * D_CONV], axis=-1)
    conv_y, conv_state = short_conv(c_gate * v, conv_prefix, conv_w)
    y_a = b_gate * conv_y
    pooled, pool_state = multi_scale_pool(p, pool_prefix, pos0)
    y_b = jnp.einsum('blgc,gcd->blgd', pooled.reshape(bsz, L, N_POOL_GROUPS, POOL_GROUP), pool_w)
    y_b = y_b.reshape(bsz, L, D_POOL) * pool_scale
    out = jnp.concatenate([y_a, y_b], axis=-1) @ w_out
    return out, conv_state, pool_state


def mem_kv(mem, g, w_kv):
    bsz = mem.shape[0]
    k, v = jnp.split(rms_norm(mem, g) @ w_kv, 2, axis=-1)
    return (k.reshape(bsz, N_MEM, N_XHEADS, XHEAD_DIM), v.reshape(bsz, N_MEM, N_XHEADS, XHEAD_DIM))


def cross_attend(h, k, v, wq, wo):
    bsz, L, _ = h.shape
    q = (h @ wq).reshape(bsz, L, N_XHEADS, XHEAD_DIM)
    s = jnp.einsum('blhd,bmhd->bhlm', q, k.astype(q.dtype)).astype(jnp.float32) * (XHEAD_DIM ** -0.5)
    pr = jax.nn.softmax(s, axis=-1).astype(h.dtype)
    o = jnp.einsum('bhlm,bmhd->blhd', pr, v.astype(h.dtype)).reshape(bsz, L, D_MODEL)
    return o @ wo


def setup_inputs(seed: int = 0) -> dict:
    key = jax.random.key(seed)
    ks = jax.random.split(key, 24)
    nrm = lambda k, shape, s: jax.random.normal(k, shape, jnp.float32) * s
    return {
        "x_prompt": nrm(ks[0], (BATCH, SEQ, D_MODEL), 1.0),
        "x_sample": nrm(ks[1], (DEC_BATCH, DEC_SEQ, D_MODEL), 1.0),
        "mem_prompt": nrm(ks[2], (BATCH, N_MEM, D_MODEL), 1.0),
        "cache_mem_k": nrm(ks[3], (DEPTH, DEC_BATCH, N_MEM, N_XHEADS, XHEAD_DIM), 1.0),
        "cache_mem_v": nrm(ks[4], (DEPTH, DEC_BATCH, N_MEM, N_XHEADS, XHEAD_DIM), 1.0),
        "state_conv": nrm(ks[5], (DEPTH, DEC_BATCH, CONV_WIDTH - 1, D_CONV), 1.0),
        "state_pool": nrm(ks[6], (DEPTH, DEC_BATCH, POOL_STATE, D_POOL), 1.0),
        "ffn_norm": 1.0 + nrm(ks[7], (DEPTH, 2, D_MODEL), 0.05),
        "ffn_w_in": nrm(ks[8], (DEPTH, 2, D_MODEL, 2 * D_FF), D_MODEL ** -0.5),
        "ffn_w_out": nrm(ks[9], (DEPTH, 2, D_FF, D_MODEL), D_FF ** -0.5),
        "mix_norm": 1.0 + nrm(ks[10], (DEPTH, D_MODEL), 0.05),
        "mix_w_in": nrm(ks[11], (DEPTH, D_MODEL, D_IN), D_MODEL ** -0.5),
        "conv_w": nrm(ks[12], (DEPTH, CONV_WIDTH, D_CONV), CONV_WIDTH ** -0.5),
        "pool_w": nrm(ks[13], (DEPTH, N_POOL_GROUPS, POOL_GROUP, POOL_GROUP), POOL_GROUP ** -0.5),
        "pool_scale": 1.0 + nrm(ks[14], (DEPTH, D_POOL), 0.05),
        "mix_w_out": nrm(ks[15], (DEPTH, D_MIX, D_MODEL), D_MIX ** -0.5),
        "xattn_norm": 1.0 + nrm(ks[16], (DEPTH, D_MODEL), 0.05),
        "mem_norm": 1.0 + nrm(ks[17], (DEPTH, D_MODEL), 0.05),
        "xattn_wq": nrm(ks[18], (DEPTH, D_MODEL, D_MODEL), D_MODEL ** -0.5),
        "xattn_wkv": nrm(ks[19], (DEPTH, D_MODEL, 2 * D_MODEL), D_MODEL ** -0.5),
        "xattn_wo": nrm(ks[20], (DEPTH, D_MODEL, D_MODEL), D_MODEL ** -0.5),
        "final_norm": 1.0 + nrm(ks[21], (D_MODEL,), 0.05),
    }


def reference(x_prompt, x_sample, mem_prompt, cache_mem_k, cache_mem_v, state_conv, state_pool,
              ffn_norm, ffn_w_in, ffn_w_out, mix_norm, mix_w_in, conv_w, pool_w, pool_scale, mix_w_out,
              xattn_norm, mem_norm, xattn_wq, xattn_wkv, xattn_wo, final_norm):
    def layer(x, l, conv_prefix, pool_prefix, pos0, mk, mv):
        x = x + 0.5 * swiglu_ffn(rms_norm(x, ffn_norm[l, 0]), ffn_w_in[l, 0], ffn_w_out[l, 0])
        mix, conv_state, pool_state = token_mix(rms_norm(x, mix_norm[l]), conv_prefix, pool_prefix, pos0,
                                                mix_w_in[l], conv_w[l], pool_w[l], pool_scale[l], mix_w_out[l])
        x = x + mix
        x = x + cross_attend(rms_norm(x, xattn_norm[l]), mk, mv, xattn_wq[l], xattn_wo[l])
        x = x + 0.5 * swiglu_ffn(rms_norm(x, ffn_norm[l, 1]), ffn_w_in[l, 1], ffn_w_out[l, 1])
        return x, conv_state, pool_state

    bp = x_prompt.shape[0]
    zero_conv = jnp.zeros((bp, CONV_WIDTH - 1, D_CONV), x_prompt.dtype)
    zero_pool = jnp.zeros((bp, POOL_STATE, D_POOL), x_prompt.dtype)
    xp = x_prompt
    mk_p, mv_p, conv_p, pool_p = [], [], [], []
    for l in range(DEPTH):
        mk, mv = mem_kv(mem_prompt, mem_norm[l], xattn_wkv[l])
        xp, cst, pst = layer(xp, l, zero_conv, zero_pool, 0, mk, mv)
        mk_p.append(mk); mv_p.append(mv); conv_p.append(cst); pool_p.append(pst)
    y_prompt = rms_norm(xp, final_norm)

    xs = x_sample
    conv_s, pool_s = [], []
    for l in range(DEPTH):
        xs, cst, pst = layer(xs, l, state_conv[l], state_pool[l], PAST_LEN, cache_mem_k[l], cache_mem_v[l])
        conv_s.append(cst); pool_s.append(pst)
    y_sample = rms_norm(xs, final_norm)

    mem_k_prompt = jnp.stack(mk_p)
    mem_v_prompt = jnp.stack(mv_p)
    conv_state_prompt = jnp.stack(conv_p)
    pool_state_prompt = jnp.stack(pool_p)
    conv_state_sample = jnp.stack(conv_s)
    pool_state_sample = jnp.stack(pool_s)
    return (y_prompt, y_sample, mem_k_prompt, mem_v_prompt, conv_state_prompt, pool_state_prompt,
            conv_state_sample, pool_state_sample)
```

```cpp
#include <hip/hip_runtime.h>
#include <hip/hip_cooperative_groups.h>
#include <cstdio>
#include <cstdint>
namespace cg = cooperative_groups;

#define LAS __attribute__((address_space(3)))
typedef unsigned short bf16_t;
typedef short bf16x8 __attribute__((ext_vector_type(8)));
typedef float f32x4 __attribute__((ext_vector_type(4)));
typedef float f32x2 __attribute__((ext_vector_type(2)));
typedef unsigned u32x4 __attribute__((ext_vector_type(4)));
typedef unsigned u32x2 __attribute__((ext_vector_type(2)));

constexpr int D = 1024, SEQ = 4096, NB = 8, MP = NB * SEQ, MS = 256, MT = MP + MS, FF = 2816, DIN = 2048;
constexpr int NMEM = 256, NH = 4, HD = 256, SB = 16, SL = 16;
constexpr float EPS = 1e-6f;
constexpr float QSCALE = 0.0625f * 1.4426950408889634f;

constexpr size_t O_Y = 0, O_MK = (size_t)MT * D, O_MV = O_MK + (size_t)2 * 2048 * 1024, O_CSP = O_MV + (size_t)2 * 2048 * 1024,
                 O_PSP = O_CSP + 2 * 8 * 2 * 512, O_CSS = O_PSP + 2 * 8 * 15 * 512, O_PSS = O_CSS + 2 * 16 * 2 * 512, O_END = O_PSS + 2 * 16 * 15 * 512;

constexpr size_t MiB = 1u << 20;
constexpr size_t WS_SSQ = 1 * MiB, WS_RSM = 4 * MiB, WS_W = 8 * MiB;
constexpr size_t W_L = 43 * MiB;
constexpr size_t W_1 = 0, W_2 = 11 * MiB, W_1B = 33 * MiB / 2, W_2B = 55 * MiB / 2, W_M = 33 * MiB, W_O2 = 37 * MiB, W_Q = 39 * MiB, W_O = 41 * MiB;
constexpr size_t WS_WKV = WS_W + 2 * W_L;
constexpr size_t WS_XB = 102 * MiB, WS_R1 = 167 * MiB, WS_R2 = 345 * MiB, WS_MEMB = 410 * MiB, WS_KB = 414 * MiB, WS_VT = 422 * MiB, WS_VW = 430 * MiB, WS_END = 462 * MiB;
static_assert(W_1B == W_2 + (size_t)1024 * 2816 * 2 && W_2B == W_1B + 11 * MiB && W_2B + (size_t)1024 * 2816 * 2 == W_M, "weights map");
static_assert(WS_XB + (size_t)MT * D * 2 <= WS_R1 && WS_R1 + (size_t)MT * FF * 2 <= WS_R2 && WS_R2 + (size_t)MT * D * 2 <= WS_MEMB, "ws map");

constexpr int RING_BYTES = 131072, XCH_OFF = RING_BYTES + 1024, RS_OFF = XCH_OFF + 8192, LDS_BYTES = 147456;

__device__ __forceinline__ unsigned cvt_pk_bf16(float lo, float hi) { unsigned r; asm volatile("v_cvt_pk_bf16_f32 %0, %1, %2" : "=v"(r) : "v"(lo), "v"(hi)); return r; }
__device__ __forceinline__ float bf_lo(unsigned w) { return __uint_as_float(w << 16); }
__device__ __forceinline__ float bf_hi(unsigned w) { return __uint_as_float(w & 0xffff0000u); }
__device__ __forceinline__ float wave_sum(float v) {
#pragma unroll
    for (int o = 1; o < 64; o <<= 1) v += __shfl_xor(v, o);
    return v;
}
__device__ __forceinline__ float wave_max(float v) {
#pragma unroll
    for (int o = 1; o < 64; o <<= 1) v = fmaxf(v, __shfl_xor(v, o));
    return v;
}
__device__ __forceinline__ float row_rstd(const float* ssq, int row) {
    const f32x4* p = (const f32x4*)(ssq + (size_t)row * 16);
    const f32x4 a = p[0], b = p[1], c = p[2], d = p[3];
    const float s = (((a.x + a.y) + (a.z + a.w)) + ((b.x + b.y) + (b.z + b.w))) + (((c.x + c.y) + (c.z + c.w)) + ((d.x + d.y) + (d.z + d.w)));
    return rsqrtf(s * (1.0f / 1024.0f) + EPS);
}

struct RsLoad { f32x4 a0, b0, c0, d0, a1, b1, c1, d1; };
__device__ __forceinline__ void rs_issue(const float* ssq, int rbase, RsLoad& L) {
    const int lane = threadIdx.x & 63;
    const f32x4* p0 = (const f32x4*)(ssq + (size_t)(rbase + lane) * 16); const f32x4* p1 = (const f32x4*)(ssq + (size_t)(rbase + 128 + lane) * 16);
    L.a0 = p0[0]; L.b0 = p0[1]; L.c0 = p0[2]; L.d0 = p0[3]; L.a1 = p1[0]; L.b1 = p1[1]; L.c1 = p1[2]; L.d1 = p1[3];
    asm volatile("" ::: "memory");
}
__device__ __forceinline__ void rs_reduce(const RsLoad& L, float& r0, float& r1) {
    const f32x4 t0 = (L.a0 + L.b0) + (L.c0 + L.d0), t1 = (L.a1 + L.b1) + (L.c1 + L.d1);
    r0 = rsqrtf(((t0.x + t0.y) + (t0.z + t0.w)) * (1.0f / 1024.0f) + EPS); r1 = rsqrtf(((t1.x + t1.y) + (t1.z + t1.w)) * (1.0f / 1024.0f) + EPS);
}
__device__ __forceinline__ void rs_spread(float r0, float r1, int fr, float (&rs)[2][4]) {
#pragma unroll
    for (int m = 0; m < 4; ++m) { rs[0][m] = __shfl(r0, m * 16 + fr); rs[1][m] = __shfl(r1, m * 16 + fr); }
}

namespace pg8 {
constexpr int BM = 256, BK = 64, HALF = 128, HTB = HALF * BK * 2, NXCD = 8, WGM = 8;
__host__ __device__ __forceinline__ int lds_byte(int r, int c) { const int st = (r >> 4) * 2 + (c >> 5), rr = r & 15, cc = c & 31, ob = rr * 64 + cc * 2; return st * 1024 + (ob ^ (((ob >> 9) & 1) << 5)); }
__host__ __device__ __forceinline__ void stage_rc(int b, int& R, int& C) { const int st = b / 1024, sb = b % 1024, swz = sb ^ (((sb >> 9) & 1) << 5); R = (st >> 1) * 16 + swz / 64; C = (st & 1) * 32 + (swz % 64) / 2; }
__host__ __device__ __forceinline__ int perm32(int rho) { const int n = rho >> 4, i = rho & 15; return 8 * (i >> 2) + 4 * n + (i & 3); }

struct Unit { int pm, pn; };
struct Gemm { const bf16_t* A; const bf16_t* Bt; int lda, ldb, K, bmode; };
__device__ __forceinline__ size_t a_off(const Gemm& g, const Unit& u) {
    if (g.bmode == 4) return ((size_t)(u.pm & 3) * 256 * g.lda + (size_t)u.pn * 256) * 2 + (size_t)(u.pm >> 5) * W_L;
    size_t e = (size_t)u.pm * 256 * g.lda; if (g.bmode == 1 || g.bmode == 2) e += (size_t)u.pn * 256; return e * 2; }
__device__ __forceinline__ size_t b_off(const Gemm& g, const Unit& u) {
    if (g.bmode == 0) return (size_t)u.pn * 256 * g.ldb * 2;
    if (g.bmode == 1) return ((size_t)(u.pm >> 4) * 256 * g.ldb + (size_t)u.pn * 256) * 2;
    if (g.bmode == 2) return (size_t)((u.pm >> 4) * 4 + u.pn) * 65536 * 2;
    if (g.bmode == 3) return ((size_t)(u.pm >> 4) * 1024 * 1024 + (size_t)u.pn * 256 * 1024) * 2;
    return ((size_t)(u.pm >> 2) * 256 * g.ldb + (size_t)u.pn * 256) * 2;
}

struct StaticOrder {
    int nN, nig, q, step, off, gid, idx;
    __device__ void init(int M, int N, int G_, int c_) {
        const int nM = M / BM; nN = N / BM; nig = WGM * nN; const int nwg = nM * nN;
        if (G_ % NXCD == 0) { q = nwg / NXCD; step = G_ / NXCD; off = c_ / NXCD; const int w0 = (c_ % NXCD) * q + off; gid = w0 / nig; idx = w0 % nig; }
        else { q = nwg; step = G_; off = c_; gid = c_ / nig; idx = c_ % nig; }
    }
    __device__ bool next(int i, Unit& u) {
        if (i) { off += step; idx += step; while (idx >= nig) { idx -= nig; ++gid; } }
        if (off >= q) return false;
        u.pm = gid * WGM + (idx & (WGM - 1)); u.pn = idx >> 3; return true;
    }
};

template <class Epi, class Sched>
__device__ __forceinline__ void gemm_phase(LAS unsigned char* lds, const Gemm g, Sched S, const Epi& E) {
    int tid_ = threadIdx.x; asm volatile("" : "+v"(tid_));
    const int tid = tid_, wid = __builtin_amdgcn_readfirstlane(tid >> 6), lane = tid & 63, wr = wid >> 2, wc = wid & 3, fr = lane & 15, fq = lane >> 4;
    const int K = g.K, nt = K / BK;
    unsigned voffA[2], voffB[2];
#pragma unroll
    for (int i = 0; i < 2; ++i) { int R, C; stage_rc(tid * 16 + i * 8192, R, C); const int Rb = Epi::PERM ? ((R & ~31) + perm32(R & 31)) : R;
        voffA[i] = (unsigned)(R * g.lda + C) * 2u; voffB[i] = (unsigned)(Rb * g.ldb + C) * 2u; }
    const size_t kstep = (size_t)(BK * 2);
    const size_t hstepA = (size_t)HALF * g.lda * 2, hstepB = (size_t)HALF * g.ldb * 2;
    const unsigned ldsw = (unsigned)wid * 1024u;
    const int aoff = lds_byte(wr * 64 + fr, fq * 8), boff = lds_byte(wc * 32 + fr, fq * 8);
#define PG8_SA(b, h) (((b) * 2 + (h)) * HTB)
#define PG8_SB(b, h) ((4 + (b) * 2 + (h)) * HTB)
#define PG8_STAGE(bufoff, gbase, voff) do { _Pragma("unroll") for (int _i = 0; _i < 2; ++_i) \
        __builtin_amdgcn_global_load_lds((const unsigned*)((const char*)(gbase) + (voff)[_i]), (LAS unsigned*)(lds + (bufoff) + ldsw + _i * 8192), 16, 0, 0); } while (0)
#define PG8_LDA(dst, b, h) do { _Pragma("unroll") for (int m = 0; m < 4; ++m) _Pragma("unroll") for (int k = 0; k < 2; ++k) dst[m][k] = *(const LAS bf16x8*)(lds + PG8_SA(b, h) + aoff + m * 2048 + k * 1024); } while (0)
#define PG8_LDB(dst, b, h) do { _Pragma("unroll") for (int n = 0; n < 2; ++n) _Pragma("unroll") for (int k = 0; k < 2; ++k) dst[n][k] = *(const LAS bf16x8*)(lds + PG8_SB(b, h) + boff + n * 2048 + k * 1024); } while (0)
#define PG8_MMA(ai, bj, At, Bt) do { __builtin_amdgcn_s_setprio(1); _Pragma("unroll") for (int m = 0; m < 4; ++m) _Pragma("unroll") for (int n = 0; n < 2; ++n) _Pragma("unroll") for (int k = 0; k < 2; ++k) \
        acc[ai][bj][m][n] = __builtin_amdgcn_mfma_f32_16x16x32_bf16(Bt[n][k], At[m][k], acc[ai][bj][m][n], 0, 0, 0); __builtin_amdgcn_s_setprio(0); } while (0)
#define PG8_WAIT_V(n) asm volatile("s_waitcnt vmcnt(" #n ")" ::: "memory")
#define PG8_WAIT_L(n) asm volatile("s_waitcnt lgkmcnt(" #n ")" ::: "memory")
#define PG8_BAR __builtin_amdgcn_s_barrier()
#define PG8_SCHED __builtin_amdgcn_sched_barrier(0)
    Unit cur, nxt; int ui = 0;
    if (!S.next(0, cur)) return;
    f32x4 acc[2][2][4][2];
#pragma unroll
    for (int a = 0; a < 2; ++a)
#pragma unroll
        for (int b = 0; b < 2; ++b)
#pragma unroll
            for (int m = 0; m < 4; ++m)
#pragma unroll
                for (int n = 0; n < 2; ++n) acc[a][b][m][n] = (f32x4){0.f, 0.f, 0.f, 0.f};
    bf16x8 At[4][2], B0[2][2], B1[2][2];
    const char* cA = (const char*)g.A + a_off(g, cur); const char* cB = (const char*)g.Bt + b_off(g, cur);
    LAS float* rst = (LAS float*)(lds + RS_OFF) + wid * 128;
    if (Epi::NEEDS_RS && E.ssq) { RsLoad L; float r0, r1; rs_issue(E.ssq, cur.pm * 256 + wr * 64, L); rs_reduce(L, r0, r1); rst[lane] = r0; rst[64 + lane] = r1; }
    PG8_STAGE(PG8_SB(0, 0), cB, voffB); PG8_STAGE(PG8_SB(0, 1), cB + hstepB, voffB); PG8_STAGE(PG8_SA(0, 0), cA, voffA); PG8_STAGE(PG8_SA(0, 1), cA + hstepA, voffA);
    if (wr == 1) PG8_BAR;
    PG8_WAIT_V(2); PG8_BAR;
    PG8_STAGE(PG8_SB(1, 0), cB + kstep, voffB); PG8_STAGE(PG8_SA(1, 0), cA + kstep, voffA); PG8_STAGE(PG8_SB(1, 1), cB + hstepB + kstep, voffB);
    PG8_WAIT_V(6); PG8_BAR;
    for (;;) {
        const bool has_next = S.next(ui + 1, nxt);
        const char* nA = has_next ? (const char*)g.A + a_off(g, nxt) : cA; const char* nB = has_next ? (const char*)g.Bt + b_off(g, nxt) : cB;
        for (int t = 0; t < nt; t += 2) {
            const bool last = (t == nt - 2);
            const char* a1 = cA + (size_t)(t + 1) * kstep;
            const char* a2 = last ? nA : cA + (size_t)(t + 2) * kstep; const char* b2 = last ? nB : cB + (size_t)(t + 2) * kstep;
            const char* a3 = a2 + kstep; const char* b3 = b2 + kstep;
            PG8_LDB(B0, 0, 0); PG8_LDB(B1, 0, 1); PG8_SCHED; PG8_LDA(At, 0, 0); PG8_STAGE(PG8_SA(1, 1), a1 + hstepA, voffA);
            PG8_WAIT_V(8); PG8_WAIT_L(0); PG8_BAR; PG8_MMA(0, 0, At, B0); PG8_MMA(0, 1, At, B1); PG8_BAR; PG8_SCHED;
            PG8_LDA(At, 0, 1); PG8_STAGE(PG8_SB(0, 0), b2, voffB); PG8_STAGE(PG8_SB(0, 1), b2 + hstepB, voffB); PG8_STAGE(PG8_SA(0, 0), a2, voffA);
            PG8_WAIT_V(8); PG8_WAIT_L(0); PG8_BAR; PG8_MMA(1, 0, At, B0); PG8_MMA(1, 1, At, B1); PG8_BAR; PG8_SCHED;
            PG8_LDB(B0, 1, 0); PG8_LDB(B1, 1, 1); PG8_SCHED; PG8_LDA(At, 1, 0); PG8_STAGE(PG8_SA(0, 1), a2 + hstepA, voffA);
            PG8_WAIT_V(8); PG8_WAIT_L(0); PG8_BAR; PG8_MMA(0, 0, At, B0); PG8_MMA(0, 1, At, B1); PG8_BAR; PG8_SCHED;
            PG8_LDA(At, 1, 1); PG8_STAGE(PG8_SB(1, 0), b3, voffB); PG8_STAGE(PG8_SB(1, 1), b3 + hstepB, voffB); PG8_STAGE(PG8_SA(1, 0), a3, voffA);
            PG8_WAIT_V(8); PG8_WAIT_L(0); PG8_BAR; PG8_MMA(1, 0, At, B0); PG8_MMA(1, 1, At, B1); PG8_BAR; PG8_SCHED;
        }
        if (wr == 0) PG8_BAR;
        if (Epi::NEEDS_RS && E.ssq && has_next) {
            RsLoad L; float r0, r1; rs_issue(E.ssq, nxt.pm * 256 + wr * 64, L);
            E(acc, cur, wr, wc, fr, fq, lds, rst);
            rs_reduce(L, r0, r1); rst[lane] = r0; rst[64 + lane] = r1;
        } else E(acc, cur, wr, wc, fr, fq, lds, rst);
        if (!has_next) break;
#pragma unroll
        for (int a = 0; a < 2; ++a)
#pragma unroll
            for (int b = 0; b < 2; ++b)
#pragma unroll
                for (int m = 0; m < 4; ++m)
#pragma unroll
                    for (int n = 0; n < 2; ++n) acc[a][b][m][n] = (f32x4){0.f, 0.f, 0.f, 0.f};
        cur = nxt; cA = nA; cB = nB; ++ui;
        if (wr == 1) PG8_BAR;
    }
    PG8_WAIT_V(0);
    PG8_BAR;
#undef PG8_SA
#undef PG8_SB
#undef PG8_STAGE
#undef PG8_LDA
#undef PG8_LDB
#undef PG8_MMA
#undef PG8_WAIT_V
#undef PG8_WAIT_L
#undef PG8_BAR
#undef PG8_SCHED
}
}

using pg8::Unit;
typedef f32x4 Acc[2][2][4][2];

struct EpiSwiglu {
    static constexpr bool PERM = true, NEEDS_RS = true;
    bf16_t* O; const float* ssq;
    __device__ __forceinline__ void operator()(Acc& acc, const Unit& u, int wr, int wc, int fr, int fq, LAS unsigned char*, const LAS float* rst) const {
        const int row0 = u.pm * 256 + wr * 64 + fr, col0 = u.pn * 128 + wc * 32 + 8 * fq;
        float rsv[2][4];
#pragma unroll
        for (int m = 0; m < 4; ++m) { rsv[0][m] = rst[m * 16 + fr]; rsv[1][m] = rst[64 + m * 16 + fr]; }
#pragma unroll
        for (int ai = 0; ai < 2; ++ai)
#pragma unroll
            for (int m = 0; m < 4; ++m) {
                const int row = row0 + ai * 128 + m * 16; const float rs = rsv[ai][m];
                const float cexp = -1.4426950408889634f * rs, rs2 = rs * rs;
                unsigned w[4];
#pragma unroll
                for (int n = 0; n < 2; ++n)
#pragma unroll
                    for (int p = 0; p < 2; ++p) { const f32x2 g2 = {acc[ai][0][m][n][2 * p], acc[ai][0][m][n][2 * p + 1]}, u2 = {acc[ai][1][m][n][2 * p], acc[ai][1][m][n][2 * p + 1]};
                        f32x2 e2 = g2 * cexp; e2.x = __builtin_amdgcn_exp2f(e2.x); e2.y = __builtin_amdgcn_exp2f(e2.y);
                        const f32x2 d2 = e2 + 1.0f; f32x2 r2; r2.x = __builtin_amdgcn_rcpf(d2.x); r2.y = __builtin_amdgcn_rcpf(d2.y);
                        const f32x2 o2 = ((g2 * u2) * rs2) * r2; w[n * 2 + p] = cvt_pk_bf16(o2.x, o2.y); }
                *(u32x4*)(O + (size_t)row * FF + col0) = (u32x4){w[0], w[1], w[2], w[3]};
            }
    }
};
struct EpiScale {
    static constexpr bool PERM = true, NEEDS_RS = true;
    bf16_t* O; int ldc; const float* ssq;
    __device__ __forceinline__ void operator()(Acc& acc, const Unit& u, int wr, int wc, int fr, int fq, LAS unsigned char*, const LAS float* rst) const {
        const int row0 = u.pm * 256 + wr * 64 + fr, col0 = u.pn * 256 + wc * 32 + 8 * fq;
        float rsv[2][4];
#pragma unroll
        for (int m = 0; m < 4; ++m) { rsv[0][m] = ssq ? rst[m * 16 + fr] : 1.0f; rsv[1][m] = ssq ? rst[64 + m * 16 + fr] : 1.0f; }
#pragma unroll
        for (int ai = 0; ai < 2; ++ai)
#pragma unroll
            for (int m = 0; m < 4; ++m) {
                const int row = row0 + ai * 128 + m * 16; const float rs = rsv[ai][m];
#pragma unroll
                for (int bj = 0; bj < 2; ++bj) { const f32x4 v0 = acc[ai][bj][m][0] * rs, v1 = acc[ai][bj][m][1] * rs;
                    u32x4 w; w.x = cvt_pk_bf16(v0[0], v0[1]); w.y = cvt_pk_bf16(v0[2], v0[3]); w.z = cvt_pk_bf16(v1[0], v1[1]); w.w = cvt_pk_bf16(v1[2], v1[3]);
                    *(u32x4*)(O + (size_t)row * ldc + col0 + bj * 128) = w; }
            }
    }
};
struct EpiResid {
    static constexpr bool PERM = true, NEEDS_RS = false;
    bf16_t* XB; float* ssq; float scale;
    __device__ __forceinline__ void operator()(Acc& acc, const Unit& u, int wr, int wc, int fr, int fq, LAS unsigned char*, const LAS float* rst) const {
        const int row0 = u.pm * 256 + wr * 64 + fr, col0 = u.pn * 256 + wc * 32 + 8 * fq;
#pragma unroll
        for (int ai = 0; ai < 2; ++ai) {
            u32x4 xo[4][2];
#pragma unroll
            for (int m = 0; m < 4; ++m) { const size_t off = (size_t)(row0 + ai * 128 + m * 16) * D + col0;
#pragma unroll
                for (int bj = 0; bj < 2; ++bj) xo[m][bj] = *(const u32x4*)(XB + off + bj * 128); }
            asm volatile("" ::: "memory");
#pragma unroll
            for (int m = 0; m < 4; ++m) {
                const int row = row0 + ai * 128 + m * 16; const size_t off = (size_t)row * D + col0; float s = 0.f;
#pragma unroll
                for (int bj = 0; bj < 2; ++bj) { const f32x4 a0 = acc[ai][bj][m][0], a1 = acc[ai][bj][m][1]; const u32x4 o = xo[m][bj];
                    const float n0 = bf_lo(o.x) + a0[0] * scale, n1 = bf_hi(o.x) + a0[1] * scale, n2 = bf_lo(o.y) + a0[2] * scale, n3 = bf_hi(o.y) + a0[3] * scale;
                    const float n4 = bf_lo(o.z) + a1[0] * scale, n5 = bf_hi(o.z) + a1[1] * scale, n6 = bf_lo(o.w) + a1[2] * scale, n7 = bf_hi(o.w) + a1[3] * scale;
                    u32x4 w; w.x = cvt_pk_bf16(n0, n1); w.y = cvt_pk_bf16(n2, n3); w.z = cvt_pk_bf16(n4, n5); w.w = cvt_pk_bf16(n6, n7); *(u32x4*)(XB + off + bj * 128) = w;
                    s += ((n0 * n0 + n1 * n1) + (n2 * n2 + n3 * n3)) + ((n4 * n4 + n5 * n5) + (n6 * n6 + n7 * n7)); }
                s += __shfl_xor(s, 16); s += __shfl_xor(s, 32);
                if (fq == 0) ssq[(size_t)row * 16 + u.pn * 4 + wc] = s;
            }
            asm volatile("" ::: "memory");
        }
    }
};
struct EpiKV {
    static constexpr bool PERM = false, NEEDS_RS = false;
    float* dK; float* dV; bf16_t* Kb; bf16_t* Vt; const float* rsm; const float* ssq = nullptr;
    __device__ __forceinline__ void operator()(Acc& acc, const Unit& u, int wr, int wc, int fr, int fq, LAS unsigned char*, const LAS float* rst) const {
        const int l = u.pn >> 3, isV = (u.pn >> 2) & 1, h = u.pn & 3;
        const int row0 = u.pm * 256 + wr * 64 + fr, cc0 = h * 256 + wc * 32 + 4 * fq;
        float* dst = (isV ? dV : dK) + (size_t)l * 2048 * 1024;
#pragma unroll
        for (int ai = 0; ai < 2; ++ai)
#pragma unroll
            for (int m = 0; m < 4; ++m) {
                const int row = row0 + ai * 128 + m * 16; const float rs = rsm[row];
#pragma unroll
                for (int bj = 0; bj < 2; ++bj)
#pragma unroll
                    for (int n = 0; n < 2; ++n) { const f32x4 v = acc[ai][bj][m][n] * rs; const int cc = cc0 + bj * 128 + n * 16;
                        *(f32x4*)(dst + (size_t)row * 1024 + cc) = v;
                        if (!isV) { u32x2 w; w.x = cvt_pk_bf16(v[0], v[1]); w.y = cvt_pk_bf16(v[2], v[3]); *(u32x2*)(Kb + ((size_t)l * 2048 + row) * 1024 + cc) = w; }
                        else { u32x2 w; w.x = cvt_pk_bf16(v[0], v[1]); w.y = cvt_pk_bf16(v[2], v[3]); *(u32x2*)(Vt + ((size_t)l * 2048 + row) * 1024 + cc) = w; } }
            }
    }
};
struct EpiSoftmax {
    static constexpr bool PERM = true, NEEDS_RS = false;
    bf16_t* P; const float* ssq = nullptr;
    __device__ __forceinline__ void operator()(Acc& acc, const Unit& u, int wr, int wc, int fr, int fq, LAS unsigned char* lds, const LAS float* rst) const {
        unsigned xw = (unsigned)XCH_OFF + (unsigned)(((wr * 64 + fr) * 4 + wc) * 8), xr = (unsigned)XCH_OFF + (unsigned)((wr * 64 + fr) * 32);
        asm volatile("" : "+v"(xw), "+v"(xr));
        LAS f32x2* Xw = (LAS f32x2*)(lds + xw); const LAS f32x4* Xr = (const LAS f32x4*)(lds + xr);
#pragma unroll
        for (int ai = 0; ai < 2; ++ai)
#pragma unroll
            for (int m = 0; m < 4; ++m) {
                float mx = -INFINITY;
#pragma unroll
                for (int bj = 0; bj < 2; ++bj)
#pragma unroll
                    for (int n = 0; n < 2; ++n) { const f32x4 v = acc[ai][bj][m][n]; mx = fmaxf(mx, fmaxf(fmaxf(v[0], v[1]), fmaxf(v[2], v[3]))); }
                mx = fmaxf(mx, __shfl_xor(mx, 16)); mx = fmaxf(mx, __shfl_xor(mx, 32));
                float s = 0.f;
#pragma unroll
                for (int bj = 0; bj < 2; ++bj)
#pragma unroll
                    for (int n = 0; n < 2; ++n) { f32x4 v = acc[ai][bj][m][n];
#pragma unroll
                        for (int j = 0; j < 4; ++j) v[j] = __builtin_amdgcn_exp2f(v[j] - mx);
                        acc[ai][bj][m][n] = v; s += (v[0] + v[1]) + (v[2] + v[3]); }
                s += __shfl_xor(s, 16); s += __shfl_xor(s, 32);
                if (fq == 0) Xw[(ai * 128 + m * 16) * 4] = (f32x2){mx, s};
                asm volatile("" ::: "memory");
            }
        asm volatile("s_waitcnt lgkmcnt(0)" ::: "memory"); __builtin_amdgcn_s_barrier(); asm volatile("" ::: "memory");
        bf16_t* pb = P + (size_t)(u.pm * 256 + wr * 64 + fr) * D + (u.pn * 256 + wc * 32 + 8 * fq);
#pragma unroll
        for (int ai = 0; ai < 2; ++ai)
#pragma unroll
            for (int m = 0; m < 4; ++m) {
                const f32x4 p01 = Xr[(ai * 128 + m * 16) * 2], p23 = Xr[(ai * 128 + m * 16) * 2 + 1];
                const float M = fmaxf(fmaxf(p01.x, p01.z), fmaxf(p23.x, p23.z));
                const float tot = (p01.y * __builtin_amdgcn_exp2f(p01.x - M) + p01.w * __builtin_amdgcn_exp2f(p01.z - M)) + (p23.y * __builtin_amdgcn_exp2f(p23.x - M) + p23.w * __builtin_amdgcn_exp2f(p23.z - M));
                const float mine = wc == 0 ? p01.x : wc == 1 ? p01.z : wc == 2 ? p23.x : p23.z;
                const float f = __builtin_amdgcn_exp2f(mine - M) / tot;
                bf16_t* rp = pb + (size_t)(ai * 128 + m * 16) * D;
#pragma unroll
                for (int bj = 0; bj < 2; ++bj) { const f32x4 v0 = acc[ai][bj][m][0] * f, v1 = acc[ai][bj][m][1] * f;
                    u32x4 w; w.x = cvt_pk_bf16(v0[0], v0[1]); w.y = cvt_pk_bf16(v0[2], v0[3]); w.z = cvt_pk_bf16(v1[0], v1[1]); w.w = cvt_pk_bf16(v1[2], v1[3]);
                    *(u32x4*)(rp + bj * 128) = w; }
                asm volatile("" ::: "memory");
            }
    }
};

typedef float f32x16 __attribute__((ext_vector_type(16)));
struct SgArgs { const bf16_t* A; int lda; const bf16_t* Bt; int ldb, K; const float* ssq_in; bf16_t* O; int ldc; float* X; bf16_t* XB; float* ssq_out; float scale; };
template <int MODE>
__device__ __forceinline__ void sgemm_phase(LAS unsigned char* lds, const SgArgs g, int ntiles, int bid, int G) {
    int tid = threadIdx.x; asm volatile("" : "+v"(tid)); const int lane = tid & 63, wave = __builtin_amdgcn_readfirstlane(tid >> 6);
    const int r32 = lane & 31, hi = lane >> 5, kw = g.K >> 3;
    for (int t = bid; t < ntiles; t += G) {
        const int ct = t >> 3, rt = t & 7;
        const int brow0 = MODE == 0 ? 256 * (ct >> 2) + 32 * (ct & 3) : 64 * ct, brow1 = MODE == 0 ? brow0 + 128 : brow0 + 32;
        const bf16_t* ap = g.A + (size_t)(MP + rt * 32 + r32) * g.lda + wave * kw + hi * 8;
        const bf16_t* bp0 = g.Bt + (size_t)(brow0 + r32) * g.ldb + wave * kw + hi * 8;
        const bf16_t* bp1 = g.Bt + (size_t)(brow1 + r32) * g.ldb + wave * kw + hi * 8;
        f32x16 c0 = {}, c1 = {};
        for (int k0 = 0; k0 < kw; k0 += 128) {
            bf16x8 a[8], b0[8], b1[8];
#pragma unroll
            for (int i = 0; i < 8; ++i) if (k0 + 16 * i < kw) { a[i] = *(const bf16x8*)(ap + k0 + 16 * i); b0[i] = *(const bf16x8*)(bp0 + k0 + 16 * i); b1[i] = *(const bf16x8*)(bp1 + k0 + 16 * i); }
            asm volatile("" ::: "memory");
#pragma unroll
            for (int i = 0; i < 8; ++i) if (k0 + 16 * i < kw) { c0 = __builtin_amdgcn_mfma_f32_32x32x16_bf16(a[i], b0[i], c0, 0, 0, 0); c1 = __builtin_amdgcn_mfma_f32_32x32x16_bf16(a[i], b1[i], c1, 0, 0, 0); }
        }
        LAS float* red = (LAS float*)lds + wave * 2048;
#pragma unroll
        for (int r = 0; r < 16; ++r) { const int row = (r & 3) + 8 * (r >> 2) + 4 * hi; red[row * 64 + r32] = c0[r]; red[row * 64 + 32 + r32] = c1[r]; }
        __syncthreads();
        const int row = tid >> 4, q = tid & 15; float v0 = 0.f, v1 = 0.f, v2 = 0.f, v3 = 0.f;
#pragma unroll
        for (int w = 0; w < 8; ++w) { const LAS float* p = (const LAS float*)lds + w * 2048 + row * 64 + 2 * q; const f32x2 lo = *(const LAS f32x2*)p, hi2 = *(const LAS f32x2*)(p + 32); v0 += lo.x; v1 += lo.y; v2 += hi2.x; v3 += hi2.y; }
        const int grow = MP + rt * 32 + row;
        if (MODE == 0) {
            const float rs = row_rstd(g.ssq_in, grow); const float g0 = v0 * rs, g1 = v1 * rs, u0 = v2 * rs, u1 = v3 * rs;
            const float a0 = g0 * __builtin_amdgcn_rcpf(1.0f + __builtin_amdgcn_exp2f(-1.4426950408889634f * g0)) * u0, a1 = g1 * __builtin_amdgcn_rcpf(1.0f + __builtin_amdgcn_exp2f(-1.4426950408889634f * g1)) * u1;
            *(unsigned*)(g.O + (size_t)grow * g.ldc + 128 * (ct >> 2) + 32 * (ct & 3) + 2 * q) = cvt_pk_bf16(a0, a1);
        } else if (MODE == 1) {
            const float rs = row_rstd(g.ssq_in, grow); bf16_t* op = g.O + (size_t)grow * g.ldc + 64 * ct + 2 * q;
            *(unsigned*)op = cvt_pk_bf16(v0 * rs, v1 * rs); *(unsigned*)(op + 32) = cvt_pk_bf16(v2 * rs, v3 * rs);
        } else {
            const size_t off = (size_t)grow * D + 64 * ct + 2 * q;
            const unsigned xa = *(const unsigned*)(g.XB + off), xb = *(const unsigned*)(g.XB + off + 32);
            const float n0 = bf_lo(xa) + g.scale * v0, n1 = bf_hi(xa) + g.scale * v1, n2 = bf_lo(xb) + g.scale * v2, n3 = bf_hi(xb) + g.scale * v3;
            *(unsigned*)(g.XB + off) = cvt_pk_bf16(n0, n1); *(unsigned*)(g.XB + off + 32) = cvt_pk_bf16(n2, n3);
            float ss = (n0 * n0 + n1 * n1) + (n2 * n2 + n3 * n3);
            ss += __shfl_xor(ss, 1); ss += __shfl_xor(ss, 2); ss += __shfl_xor(ss, 4); ss += __shfl_xor(ss, 8);
            if (q == 0) g.ssq_out[(size_t)grow * 16 + ct] = ss;
        }
        __syncthreads();
    }
}

#define XB_TMO      128
#define XB_XCNT(j)  (256  + 64 * (j))
#define XB_XSUB(j)  (1280 + 64 * (j))
#define XB_XGEN(j)  (2304 + 64 * (j))
#define XB_TOP      3328
#define XB_TOPGEN   3392
#define XCD_BAR_WORDS 3456
#define XB_SPIN_CAP (1u << 18)
__device__ __forceinline__ unsigned xb_ld(unsigned* p)              { return __hip_atomic_load(p, __ATOMIC_RELAXED, __HIP_MEMORY_SCOPE_AGENT); }
__device__ __forceinline__ unsigned xb_add(unsigned* p, unsigned v) { return __hip_atomic_fetch_add(p, v, __ATOMIC_RELAXED, __HIP_MEMORY_SCOPE_AGENT); }
__device__ __forceinline__ unsigned xb_xcc_id() { return (unsigned)__builtin_amdgcn_s_getreg((3 << 11) | 20) & 0xFu; }
#define XB_SPIN(cond, bar) do { unsigned _sp = 0; while (cond) { __builtin_amdgcn_s_sleep(1); \
    if ((++_sp & 255u) == 0u) { if (xb_ld(&(bar)[XB_TMO])) break; if (_sp > XB_SPIN_CAP) { atomicAdd(&(bar)[XB_TMO], 1u); break; } } } } while (0)
struct XcdBarrier { unsigned* bar; unsigned x; volatile LAS unsigned* st; };
__device__ __forceinline__ XcdBarrier xcd_barrier_post(unsigned* bar, volatile LAS unsigned* st) {
    XcdBarrier b; b.bar = bar; b.x = xb_xcc_id(); b.st = st;
    if (threadIdx.x == 0) (void)xb_add(&bar[XB_XCNT(b.x)], 1u);
    return b;
}
__device__ __forceinline__ void xcd_barrier_complete(unsigned* bar, unsigned x, unsigned& nloc, unsigned& nx) {
    const unsigned G = gridDim.x * gridDim.y * gridDim.z;
    unsigned sum, cnt, mine, sp = 0u;
    for (;;) {
        sum = 0u; cnt = 0u; mine = 0u;
#pragma unroll
        for (unsigned j = 0; j < 16; ++j) { const unsigned c = xb_ld(&bar[XB_XCNT(j)]); sum += c; cnt += (c > 0u) ? 1u : 0u; mine = (j == x) ? c : mine; }
        if (sum == G) break;
        __builtin_amdgcn_s_sleep(1);
        if ((++sp & 255u) == 0u) { if (xb_ld(&bar[XB_TMO])) break; if (sp > XB_SPIN_CAP) { atomicAdd(&bar[XB_TMO], 1u); break; } }
    }
    nloc = mine > 0u ? mine : 1u; nx = cnt > 0u ? cnt : 1u;
}
__device__ __forceinline__ void xcd_barrier(const XcdBarrier& b) {
    asm volatile("s_waitcnt vmcnt(0)" ::: "memory");
    __syncthreads();
    if (threadIdx.x == 0) {
        unsigned* bar = b.bar; asm volatile("" : "+s"(bar));
        __builtin_amdgcn_s_waitcnt(0);
        const unsigned bx = xb_xcc_id();
        unsigned nloc = b.st[0], nx = b.st[1];
        if (nloc == 0u) { xcd_barrier_complete(bar, bx, nloc, nx); b.st[0] = nloc; b.st[1] = nx; }
        const unsigned old = xb_add(&bar[XB_XSUB(bx)], 1u);
        const unsigned gen = old / nloc;
        if (old + 1u == (gen + 1u) * nloc) {
            __builtin_amdgcn_fence(__ATOMIC_RELEASE, "agent");
            asm volatile("s_waitcnt vmcnt(0)" ::: "memory");
            const unsigned og = xb_add(&bar[XB_TOP], 1u);
            const unsigned tg = og / nx;
            if (og + 1u == (tg + 1u) * nx) xb_add(&bar[XB_TOPGEN], 1u);
            else XB_SPIN(xb_ld(&bar[XB_TOPGEN]) == tg, bar);
            __builtin_amdgcn_fence(__ATOMIC_ACQUIRE, "agent");
            xb_add(&bar[XB_XGEN(bx)], 1u);
            asm volatile("s_waitcnt vmcnt(0)" ::: "memory");
        } else {
            XB_SPIN(xb_ld(&bar[XB_TOPGEN]) == gen, bar);
            __builtin_amdgcn_fence(__ATOMIC_ACQUIRE, "agent");
            asm volatile("s_waitcnt vmcnt(0)" ::: "memory");
        }
    }
    __syncthreads();
}

__device__ __forceinline__ SgArgs sa_dummy(const bf16_t* A, const bf16_t* Bt, const float* ssq, bf16_t* O, int ldc) { return SgArgs{A, 1024, Bt, 1024, 1024, ssq, O, ldc, nullptr, nullptr, nullptr, 0.f}; }

struct Args { const float* in[22]; float* out; unsigned char* ws; };
struct Frame {
    LAS unsigned char* lds; int G, bid;
    const float* const* in; float* out; unsigned char* ws;
};

__device__ __forceinline__ void transpose_item(const float* W, int N, const float* gain, float scale, bf16_t* WT, int ldk, int drow0, int k0, int n0, LAS float* scr, int lane) {
    float tv[32];
    const float* wp = W + (size_t)(k0 + (lane >> 5)) * N + n0 + (lane & 31);
#pragma unroll
    for (int i = 0; i < 32; ++i) tv[i] = wp[(size_t)(2 * i) * N];
#pragma unroll
    for (int i = 0; i < 32; ++i) { const int kk = 2 * i + (lane >> 5); const float gv = gain ? gain[k0 + kk] * scale : scale;
        scr[kk * 33 + (lane & 31)] = tv[i] * gv; }
    asm volatile("s_waitcnt lgkmcnt(0)" ::: "memory");
    const int c = lane & 7;
#pragma unroll
    for (int j = 0; j < 4; ++j) { const int n = (lane >> 3) + 8 * j; const LAS float* s = scr + (8 * c) * 33 + n;
        u32x4 o; o.x = cvt_pk_bf16(s[0 * 33], s[1 * 33]); o.y = cvt_pk_bf16(s[2 * 33], s[3 * 33]); o.z = cvt_pk_bf16(s[4 * 33], s[5 * 33]); o.w = cvt_pk_bf16(s[6 * 33], s[7 * 33]);
        *(u32x4*)(WT + (size_t)(drow0 + n) * ldk + k0 + 8 * c) = o; }
    asm volatile("s_waitcnt lgkmcnt(0)" ::: "memory");
}

constexpr int TI_1 = 2816, TI_3 = 1408, TI_5 = 1024, TI_6 = 256, TI_7 = 512, TI_9 = 1024;
constexpr int TI_L = 2 * TI_1 + 2 * TI_3 + TI_5 + TI_6 + 2 * TI_7 + TI_9;
constexpr int N_TR = 2 * TI_L, N_WC = 2048, N_XR = MT, N_MR = 2048, N_P0 = N_TR + N_WC + N_XR + N_MR;

__device__ __forceinline__ void prologue(Frame& F) {
    int tid = threadIdx.x; asm volatile("" : "+v"(tid)); const int lane = tid & 63, wave = __builtin_amdgcn_readfirstlane(tid >> 6); (void)lane; (void)wave;
    LAS float* scr = (LAS float*)(F.lds + wave * 16384);
    const int gw = F.bid * 8 + wave, NGW = F.G * 8;
    unsigned char* ws = F.ws;
    for (int it = gw; it < N_TR + N_WC; it += NGW) {
        if (it < N_TR) {
            const int l = it / TI_L; int r = it % TI_L;
            unsigned char* wl = ws + WS_W + (size_t)l * W_L;
            const float* W; const float* gain = nullptr; float scale = 1.f; bf16_t* dst; int N, ldk, mode = 0;
            if (r < 2 * TI_1) { const int j = r / TI_1; r %= TI_1; W = F.in[8] + (size_t)(l * 2 + j) * 1024 * 5632; gain = F.in[7] + (l * 2 + j) * 1024; dst = (bf16_t*)(wl + (j ? W_1B : W_1)); N = 5632; ldk = 1024; mode = 1; }
            else if ((r -= 2 * TI_1) < 2 * TI_3) { const int j = r / TI_3; r %= TI_3; W = F.in[9] + (size_t)(l * 2 + j) * 2816 * 1024; dst = (bf16_t*)(wl + (j ? W_2B : W_2)); N = 1024; ldk = 2816; }
            else if ((r -= 2 * TI_3) < TI_5) { W = F.in[11] + (size_t)l * 1024 * 2048; gain = F.in[10] + l * 1024; dst = (bf16_t*)(wl + W_M); N = 2048; ldk = 1024; }
            else if ((r -= TI_5) < TI_6) { W = F.in[15] + (size_t)l * 1024 * 1024; dst = (bf16_t*)(wl + W_O2); N = 1024; ldk = 1024; }
            else if ((r -= TI_6) < TI_7) { W = F.in[18] + (size_t)l * 1024 * 1024; gain = F.in[16] + l * 1024; scale = QSCALE; dst = (bf16_t*)(wl + W_Q); N = 1024; ldk = 1024; }
            else if ((r -= TI_7) < TI_7) { W = F.in[20] + (size_t)l * 1024 * 1024; dst = (bf16_t*)(wl + W_O); N = 1024; ldk = 1024; }
            else { r -= TI_7; W = F.in[19] + (size_t)l * 1024 * 2048; gain = F.in[17] + l * 1024; dst = (bf16_t*)(ws + WS_WKV) + (size_t)l * 2048 * 1024; N = 2048; ldk = 1024; }
            const int nblk = N / 32, kb = r / nblk, nb = r % nblk, k0 = kb * 64, n0 = nb * 32;
            int drow0 = n0;
            if (mode == 1) { const int isu = n0 >= FF ? 1 : 0, i0 = n0 - isu * FF; drow0 = (i0 >> 7) * 256 + isu * 128 + (i0 & 127); }
            transpose_item(W, N, gain, scale, dst, ldk, drow0, k0, n0, scr, lane);
        } else {
            const int wi = it - N_TR, l = wi >> 10, r = wi & 1023, g = r >> 8, co = (r >> 4) & 15, nb = r & 15, n = nb * 64 + lane, c0 = co * 8;
            const float* wo = F.in[15] + (size_t)l * 1024 * 1024 + (size_t)(512 + g * 128) * 1024 + n;
            const float* ps = F.in[14] + l * 512 + g * 128;
            const float* pw = F.in[13] + (size_t)((l * 4 + g) * 128 + c0) * 128;
            float a[8];
#pragma unroll
            for (int i = 0; i < 8; ++i) a[i] = 0.f;
#pragma unroll 16
            for (int d = 0; d < 128; ++d) { const float w = wo[(size_t)d * 1024] * ps[d];
#pragma unroll
                for (int i = 0; i < 8; ++i) a[i] += pw[i * 128 + d] * w; }
            bf16_t* dst = (bf16_t*)(ws + WS_W + (size_t)l * W_L + W_O2) + (size_t)n * 1024 + 512 + g * 128 + c0;
            u32x4 o; o.x = cvt_pk_bf16(a[0], a[1]); o.y = cvt_pk_bf16(a[2], a[3]); o.z = cvt_pk_bf16(a[4], a[5]); o.w = cvt_pk_bf16(a[6], a[7]);
            *(u32x4*)dst = o;
        }
    }
    for (int m0 = gw; m0 < MT; m0 += 4 * NGW) {
        f32x4 v[4][4];
#pragma unroll
        for (int r = 0; r < 4; ++r) { const int m = m0 + r * NGW; if (m < MT) { const float* src = m < MP ? F.in[0] + (size_t)m * D : F.in[1] + (size_t)(m - MP) * D; const f32x4* xr = (const f32x4*)src + lane;
#pragma unroll
            for (int j = 0; j < 4; ++j) v[r][j] = xr[64 * j]; } }
#pragma unroll
        for (int r = 0; r < 4; ++r) { const int m = m0 + r * NGW; if (m < MT) { float s = 0.f;
#pragma unroll
            for (int j = 0; j < 4; ++j) s += (v[r][j].x * v[r][j].x + v[r][j].y * v[r][j].y) + (v[r][j].z * v[r][j].z + v[r][j].w * v[r][j].w);
            s = wave_sum(s);
            u32x2* xb = (u32x2*)((bf16_t*)(ws + WS_XB) + (size_t)m * D) + lane;
#pragma unroll
            for (int j = 0; j < 4; ++j) { u32x2 w; w.x = cvt_pk_bf16(v[r][j].x, v[r][j].y); w.y = cvt_pk_bf16(v[r][j].z, v[r][j].w); xb[64 * j] = w; }
            if (lane < 16) ((float*)(ws + WS_SSQ))[(size_t)m * 16 + lane] = lane == 0 ? s : 0.f; } }
    }
    for (int m = gw; m < N_MR; m += NGW) {
        const f32x4* xr = (const f32x4*)(F.in[2] + (size_t)m * D) + lane; f32x4 v[4]; float s = 0.f;
#pragma unroll
        for (int j = 0; j < 4; ++j) { v[j] = xr[64 * j]; s += (v[j].x * v[j].x + v[j].y * v[j].y) + (v[j].z * v[j].z + v[j].w * v[j].w); }
        s = wave_sum(s);
        u32x2* xb = (u32x2*)((bf16_t*)(ws + WS_MEMB) + (size_t)m * D) + lane;
#pragma unroll
        for (int j = 0; j < 4; ++j) { u32x2 w; w.x = cvt_pk_bf16(v[j].x, v[j].y); w.y = cvt_pk_bf16(v[j].z, v[j].w); xb[64 * j] = w; }
        if (lane == 0) ((float*)(ws + WS_RSM))[m] = rsqrtf(s * (1.0f / 1024.0f) + EPS);
    }
}

__device__ __forceinline__ void ld8(const bf16_t* p, float (&o)[8]) { const u32x4 w = *(const u32x4*)p;
    o[0] = bf_lo(w.x); o[1] = bf_hi(w.x); o[2] = bf_lo(w.y); o[3] = bf_hi(w.y); o[4] = bf_lo(w.z); o[5] = bf_hi(w.z); o[6] = bf_lo(w.w); o[7] = bf_hi(w.w); }
__device__ __forceinline__ void up8(const u32x4 w, float (&o)[8]) {
    o[0] = bf_lo(w.x); o[1] = bf_hi(w.x); o[2] = bf_lo(w.y); o[3] = bf_hi(w.y); o[4] = bf_lo(w.z); o[5] = bf_hi(w.z); o[6] = bf_lo(w.w); o[7] = bf_hi(w.w); }
__device__ __forceinline__ void ld8f(const float* p, float (&o)[8]) { const f32x4 a = *(const f32x4*)p, b = *(const f32x4*)(p + 4);
    o[0] = a.x; o[1] = a.y; o[2] = a.z; o[3] = a.w; o[4] = b.x; o[5] = b.y; o[6] = b.z; o[7] = b.w; }
__device__ __forceinline__ void st8(bf16_t* p, const float (&o)[8]) { u32x4 w; w.x = cvt_pk_bf16(o[0], o[1]); w.y = cvt_pk_bf16(o[2], o[3]); w.z = cvt_pk_bf16(o[4], o[5]); w.w = cvt_pk_bf16(o[6], o[7]); *(u32x4*)p = w; }
__device__ __forceinline__ void st8f(float* p, const float (&o)[8]) { *(f32x4*)p = (f32x4){o[0], o[1], o[2], o[3]}; *(f32x4*)(p + 4) = (f32x4){o[4], o[5], o[6], o[7]}; }

__device__ __forceinline__ void mixer_phase(Frame& F, int l) {
    const bf16_t* Z = (const bf16_t*)(F.ws + WS_R1); bf16_t* A2 = (bf16_t*)(F.ws + WS_R2);
    int tid = threadIdx.x; asm volatile("" : "+v"(tid)); const int lane = tid & 63, wave = __builtin_amdgcn_readfirstlane(tid >> 6); (void)lane; (void)wave;
    constexpr int NPI = 8 * 128 * 128, NSI = 16 * 128;
    for (int it = F.bid * 512 + tid; it < NPI + NSI; it += F.G * 512) {
        const bool samp = it >= NPI; int oct, s, t0, T; size_t rowbase;
        if (!samp) { oct = it & 127; t0 = ((it >> 7) & 127) * 32; s = it >> 14; T = 32; rowbase = (size_t)s * SEQ; }
        else { const int j = it - NPI; oct = j & 127; s = j >> 7; t0 = 0; T = 16; rowbase = (size_t)MP + s * SL; }
        const bool lastchunk = samp || (t0 + T == SEQ);
        if (oct < 64) {
            const int c0 = oct * 8;
            float w0[8], w1[8], w2[8], cv1[8], cv2[8];
            ld8f(F.in[12] + (size_t)(l * 3 + 0) * 512 + c0, w0); ld8f(F.in[12] + (size_t)(l * 3 + 1) * 512 + c0, w1); ld8f(F.in[12] + (size_t)(l * 3 + 2) * 512 + c0, w2);
            if (t0 >= 2) { float c[8], v[8]; const bf16_t* zr = Z + (rowbase + t0 - 2) * DIN; ld8(zr + 512 + c0, c); ld8(zr + 1024 + c0, v);
#pragma unroll
                for (int i = 0; i < 8; ++i) cv2[i] = c[i] * v[i];
                zr += DIN; ld8(zr + 512 + c0, c); ld8(zr + 1024 + c0, v);
#pragma unroll
                for (int i = 0; i < 8; ++i) cv1[i] = c[i] * v[i]; }
            else if (samp) { const float* st = F.in[5] + (size_t)((l * 16 + s) * 2) * 512 + c0; ld8f(st, cv2); ld8f(st + 512, cv1); }
            else {
#pragma unroll
                for (int i = 0; i < 8; ++i) { cv1[i] = 0.f; cv2[i] = 0.f; } }
            float* cst = F.out + (samp ? O_CSS + (size_t)((l * 16 + s) * 2) * 512 : O_CSP + (size_t)((l * 8 + s) * 2) * 512) + c0;
            for (int t4 = t0; t4 < t0 + T; t4 += 4) {
                u32x4 rb[4], rc[4], rv[4];
#pragma unroll
                for (int k = 0; k < 4; ++k) { const bf16_t* zr = Z + (rowbase + t4 + k) * DIN + c0; rb[k] = *(const u32x4*)zr; rc[k] = *(const u32x4*)(zr + 512); rv[k] = *(const u32x4*)(zr + 1024); }
#pragma unroll
                for (int k = 0; k < 4; ++k) { const int t = t4 + k; float b[8], c[8], v[8], y[8]; up8(rb[k], b); up8(rc[k], c); up8(rv[k], v);
#pragma unroll
                    for (int i = 0; i < 8; ++i) { const float cv = c[i] * v[i]; y[i] = b[i] * (w0[i] * cv2[i] + w1[i] * cv1[i] + w2[i] * cv); cv2[i] = cv1[i]; cv1[i] = cv; }
                    st8(A2 + (rowbase + t) * D + c0, y);
                    if (lastchunk && t >= t0 + T - 2) st8f(cst + (size_t)(t - (t0 + T - 2)) * 512, cv1); }
            }
        } else {
            const int po = oct - 64, c0 = po * 8, g = po >> 4, w = 2 << g;
            float S[8];
#pragma unroll
            for (int i = 0; i < 8; ++i) S[i] = 0.f;
            const float* pst = F.in[6] + (size_t)((l * 16 + s) * 15) * 512 + c0;
            if (samp || t0 > 0) {
#pragma unroll
                for (int k = 1; k < 16; ++k) { float p[8];
                    if (samp) ld8f(pst + (size_t)(15 - k) * 512, p); else ld8(Z + (rowbase + t0 - k) * DIN + 1536 + c0, p);
                    const float mk = k < w ? 1.0f : 0.0f;
#pragma unroll
                    for (int i = 0; i < 8; ++i) S[i] += mk * p[i]; }
            }
            float* pso = F.out + (samp ? O_PSS + (size_t)((l * 16 + s) * 15) * 512 : O_PSP + (size_t)((l * 8 + s) * 15) * 512) + c0;
            if (!samp) {
                for (int t4 = t0; t4 < t0 + T; t4 += 4) {
                    u32x4 rp[4], rq[4];
#pragma unroll
                    for (int k = 0; k < 4; ++k) { const int t = t4 + k, tp = t - w + 1; rp[k] = *(const u32x4*)(Z + (rowbase + t) * DIN + 1536 + c0);
                        rq[k] = tp >= 0 ? *(const u32x4*)(Z + (rowbase + tp) * DIN + 1536 + c0) : (u32x4){0u, 0u, 0u, 0u}; }
#pragma unroll
                    for (int k = 0; k < 4; ++k) { const int t = t4 + k; float p[8], q[8], y[8]; up8(rp[k], p); up8(rq[k], q);
                        const int cn = (t + 1 < w) ? t + 1 : w; const float ic = 1.0f / (float)cn;
#pragma unroll
                        for (int i = 0; i < 8; ++i) { S[i] += p[i]; y[i] = S[i] * ic - p[i]; S[i] -= q[i]; }
                        st8(A2 + (rowbase + t) * D + 512 + c0, y);
                        if (lastchunk && t >= t0 + T - 15) st8f(pso + (size_t)(t - (t0 + T - 15)) * 512, p); }
                }
            } else {
                for (int t4 = 0; t4 < 16; t4 += 4) {
                    u32x4 rp[4], rq[4]; f32x4 sa[4], sb[4];
#pragma unroll
                    for (int k = 0; k < 4; ++k) { const int t = t4 + k, tp = t - w + 1, tz = tp < 0 ? 0 : tp, ts = tp < 0 ? 15 + tp : 0;
                        rp[k] = *(const u32x4*)(Z + (rowbase + t) * DIN + 1536 + c0); rq[k] = *(const u32x4*)(Z + (rowbase + tz) * DIN + 1536 + c0);
                        sa[k] = *(const f32x4*)(pst + (size_t)ts * 512); sb[k] = *(const f32x4*)(pst + (size_t)ts * 512 + 4); }
#pragma unroll
                    for (int k = 0; k < 4; ++k) { const int t = t4 + k, tp = t - w + 1; float p[8], q[8], y[8]; up8(rp[k], p); up8(rq[k], q);
                        if (tp < 0) { q[0] = sa[k].x; q[1] = sa[k].y; q[2] = sa[k].z; q[3] = sa[k].w; q[4] = sb[k].x; q[5] = sb[k].y; q[6] = sb[k].z; q[7] = sb[k].w; }
                        const float ic = 1.0f / (float)w;
#pragma unroll
                        for (int i = 0; i < 8; ++i) { S[i] += p[i]; y[i] = S[i] * ic - p[i]; S[i] -= q[i]; }
                        st8(A2 + (rowbase + t) * D + 512 + c0, y);
                        if (t >= 1) st8f(pso + (size_t)(t - 1) * 512, p); }
                }
            }
        }
    }
}

__device__ __forceinline__ void sample_attn(Frame& F, int l, int item) {
    int tid = threadIdx.x; asm volatile("" : "+v"(tid)); const int lane = tid & 63, wave = __builtin_amdgcn_readfirstlane(tid >> 6); (void)lane; (void)wave;
    const int pair = item >> 2, dq = item & 3, b = pair >> 2, h = pair & 3, w = wave;
    constexpr int SP = 260;
    LAS float* Ssm = (LAS float*)F.lds;
    bf16_t* Q = (bf16_t*)(F.ws + WS_R1);
    const float* CK = F.in[3] + (size_t)(l * 16 + b) * 256 * 1024 + h * 256;
    const float* CV = F.in[4] + (size_t)(l * 16 + b) * 256 * 1024 + h * 256;
    const int r16 = lane & 15, quad = lane >> 4;
    const bf16_t* qp = Q + (size_t)(MP + b * 16 + r16) * D + h * 256 + quad * 8;
#pragma unroll
    for (int kk = 0; kk < 2; ++kk) {
        const int kt = 2 * w + kk; const float* kp = CK + (size_t)(kt * 16 + r16) * 1024 + quad * 8;
        f32x4 acc = (f32x4){0.f, 0.f, 0.f, 0.f};
#pragma unroll
        for (int c = 0; c < 8; ++c) { const bf16x8 a = *(const bf16x8*)(qp + 32 * c); const f32x4 k0 = *(const f32x4*)(kp + 32 * c), k1 = *(const f32x4*)(kp + 32 * c + 4);
            u32x4 kb; kb.x = cvt_pk_bf16(k0.x, k0.y); kb.y = cvt_pk_bf16(k0.z, k0.w); kb.z = cvt_pk_bf16(k1.x, k1.y); kb.w = cvt_pk_bf16(k1.z, k1.w);
            acc = __builtin_amdgcn_mfma_f32_16x16x32_bf16(a, __builtin_bit_cast(bf16x8, kb), acc, 0, 0, 0); }
#pragma unroll
        for (int j = 0; j < 4; ++j) Ssm[(quad * 4 + j) * SP + kt * 16 + r16] = acc[j];
    }
    __syncthreads();
#pragma unroll
    for (int rr = 0; rr < 2; ++rr) { const int r = 2 * w + rr; f32x4 v = *(LAS f32x4*)(Ssm + r * SP + 4 * lane);
        const float mx = wave_max(fmaxf(fmaxf(v.x, v.y), fmaxf(v.z, v.w)));
        v.x = __builtin_amdgcn_exp2f(v.x - mx); v.y = __builtin_amdgcn_exp2f(v.y - mx); v.z = __builtin_amdgcn_exp2f(v.z - mx); v.w = __builtin_amdgcn_exp2f(v.w - mx);
        const float inv = 1.0f / wave_sum((v.x + v.y) + (v.z + v.w));
        *(LAS f32x4*)(Ssm + r * SP + 4 * lane) = v * inv; }
    __syncthreads();
    const int d = dq * 64 + (tid & 63), r0 = 2 * (tid >> 6);
    float o0 = 0.f, o1 = 0.f;
    const float* vp = CV + d;
    bf16_t* Osm = Q + (size_t)MS * D;
#pragma unroll 1
    for (int k0 = 0; k0 < 256; k0 += 32) {
        float vv[32];
#pragma unroll
        for (int j = 0; j < 32; ++j) vv[j] = vp[(size_t)(k0 + j) * 1024];
        asm volatile("" ::: "memory");
#pragma unroll
        for (int j = 0; j < 32; j += 4) { const f32x4 pa = *(const LAS f32x4*)(Ssm + r0 * SP + k0 + j), pb = *(const LAS f32x4*)(Ssm + (r0 + 1) * SP + k0 + j);
            o0 += (pa.x * vv[j] + pa.y * vv[j + 1]) + (pa.z * vv[j + 2] + pa.w * vv[j + 3]); o1 += (pb.x * vv[j] + pb.y * vv[j + 1]) + (pb.z * vv[j + 2] + pb.w * vv[j + 3]); }
    }
    Osm[(size_t)(MP + b * 16 + r0) * D + h * 256 + d] = (bf16_t)(cvt_pk_bf16(o0, 0.f) & 0xffffu);
    Osm[(size_t)(MP + b * 16 + r0 + 1) * D + h * 256 + d] = (bf16_t)(cvt_pk_bf16(o1, 0.f) & 0xffffu);
    __syncthreads();
}

__device__ __forceinline__ void final_norm(Frame& F) {
    int tid = threadIdx.x; asm volatile("" : "+v"(tid)); const int lane = tid & 63, wave = __builtin_amdgcn_readfirstlane(tid >> 6); (void)lane; (void)wave;
    const int gw = F.bid * 8 + wave, NGW = F.G * 8;
    const float* ssq = (const float*)(F.ws + WS_SSQ);
    const f32x4* gp = (const f32x4*)F.in[21] + lane; f32x4 gv[4];
#pragma unroll
    for (int j = 0; j < 4; ++j) gv[j] = gp[64 * j];
    for (int m = gw; m < MT; m += NGW) {
        const float rs = row_rstd(ssq, m);
        f32x4* yr = (f32x4*)(F.out + (size_t)m * D) + lane; const u32x2* xr = (const u32x2*)((const bf16_t*)(F.ws + WS_XB) + (size_t)m * D) + lane;
#pragma unroll
        for (int j = 0; j < 4; ++j) { const u32x2 o = xr[64 * j]; yr[64 * j] = (f32x4){bf_lo(o.x), bf_hi(o.x), bf_lo(o.y), bf_hi(o.y)} * rs * gv[j]; }
    }
}

__global__ void __launch_bounds__(512, 2) fwd_kernel(Args args) {
    extern __shared__ __attribute__((aligned(16))) unsigned char lds_raw[];
    cg::grid_group grid = cg::this_grid();
    Frame F;
    F.lds = (LAS unsigned char*)lds_raw;
    F.G = gridDim.x; F.bid = blockIdx.x; F.in = args.in; F.out = args.out; F.ws = args.ws;
    unsigned char* ws = args.ws;
    float* ssq = (float*)(ws + WS_SSQ);
    bf16_t* XB = (bf16_t*)(ws + WS_XB); bf16_t* R1 = (bf16_t*)(ws + WS_R1); bf16_t* R2 = (bf16_t*)(ws + WS_R2);

    volatile LAS unsigned* bst = (volatile LAS unsigned*)(F.lds + RING_BYTES + 512);
    if (threadIdx.x < 2) bst[threadIdx.x] = 0u;
    __syncthreads();
    const XcdBarrier bar = xcd_barrier_post((unsigned*)ws, bst);

    prologue(F);
    if (args.ws == nullptr) grid.sync();
    xcd_barrier(bar);

    {
        pg8::Gemm g{(const bf16_t*)(ws + WS_MEMB), (const bf16_t*)(ws + WS_WKV), 1024, 1024, 1024, 0};
        pg8::StaticOrder S; S.init(2048, 4096, F.G, F.G - 1 - F.bid);
        EpiKV E{F.out + O_MK, F.out + O_MV, (bf16_t*)(ws + WS_KB), (bf16_t*)(ws + WS_VT), (const float*)(ws + WS_RSM)};
        pg8::gemm_phase<EpiKV, pg8::StaticOrder>(F.lds, g, S, E);
    }

    for (int step = 0; step < 20; ++step) {
        const int l = step / 10, s10 = step % 10, s = s10 < 8 ? s10 : s10 + 1;
        unsigned char* ws = args.ws; float* outp = args.out; asm volatile("" : "+s"(ws), "+s"(outp));
        F.ws = ws; F.out = outp;
        float* ssq = (float*)(ws + WS_SSQ);
        bf16_t* XB = (bf16_t*)(ws + WS_XB); bf16_t* R1 = (bf16_t*)(ws + WS_R1); bf16_t* R2 = (bf16_t*)(ws + WS_R2);
        unsigned char* wl = ws + WS_W + (size_t)l * W_L;
        int two = 2; asm volatile("" : "+s"(two));
        const bool sgfirst = ((F.bid >> 3) & 1) != 0;
        if (s == 0 || s == 9) {
            pg8::Gemm g{XB, (const bf16_t*)(wl + (s == 0 ? W_1 : W_1B)), 1024, 1024, 1024, 0};
            pg8::StaticOrder S; S.init(MP, 2 * FF, F.G, F.bid);
            EpiSwiglu E{R1, ssq};
            SgArgs sa{XB, 1024, g.Bt, 1024, 1024, ssq, R1, FF, nullptr, nullptr, nullptr, 0.f};
            for (int pass = 0; pass < two; ++pass) {
                if ((pass == 0) == sgfirst) sgemm_phase<0>(F.lds, sa, 8 * 88, F.bid, F.G);
                if (pass == 0) pg8::gemm_phase<EpiSwiglu, pg8::StaticOrder>(F.lds, g, S, E);
            }
        } else if (s == 1 || s == 4 || s == 7 || s == 10) {
            pg8::Gemm g; float scale;
            if (s == 1 || s == 10) { g = pg8::Gemm{R1, (const bf16_t*)(wl + (s == 1 ? W_2 : W_2B)), FF, FF, FF, 0}; scale = 0.5f; }
            else if (s == 4) { g = pg8::Gemm{R2, (const bf16_t*)(wl + W_O2), 1024, 1024, 1024, 0}; scale = 1.0f; }
            else { g = pg8::Gemm{R1, (const bf16_t*)(ws + WS_VW) + (size_t)l * 8 * 1024 * 1024, 1024, 1024, 1024, 3}; scale = 1.0f; }
            pg8::StaticOrder S; S.init(MP, 1024, F.G, F.bid);
            EpiResid E{XB, ssq, scale};
            SgArgs sa{g.A + (s == 7 ? MS * D : 0), g.lda, s == 7 ? (const bf16_t*)(wl + W_O) : g.Bt, g.ldb, g.K, nullptr, nullptr, 0, F.out, XB, ssq, scale};
            sgemm_phase<2>(F.lds, sa, 8 * 16, F.G - 1 - F.bid, F.G);
            pg8::gemm_phase<EpiResid, pg8::StaticOrder>(F.lds, g, S, E);
        } else if (s == 2 || s == 5) {
            pg8::Gemm g; pg8::StaticOrder S; EpiScale E;
            if (s == 2) { g = pg8::Gemm{XB, (const bf16_t*)(wl + W_M), 1024, 1024, 1024, 0}; S.init(MP, DIN, F.G, F.bid); E = EpiScale{R1, DIN, ssq}; }
            else { g = pg8::Gemm{XB, (const bf16_t*)(wl + W_Q), 1024, 1024, 1024, 0}; S.init(MP, 1024, F.G, F.bid); E = EpiScale{R1, 1024, ssq}; }
            if (s == 5) sgemm_phase<1>(F.lds, sa_dummy(XB, g.Bt, ssq, R1, 1024), 8 * 16, F.G - 1 - F.bid, F.G);
            else sgemm_phase<1>(F.lds, sa_dummy(XB, g.Bt, ssq, R1, DIN), 8 * 32, sgfirst ? ((F.bid >> 4) * 8 + (F.bid & 7)) : 8 * 32, F.G / 2);
            const int nsub = (s == 5 && l == 0) ? two : 1;
            for (int sub = 0; sub < nsub; ++sub) {
                if (sub == 1) {
                    g = pg8::Gemm{(const bf16_t*)(wl + W_O), (const bf16_t*)(ws + WS_VT), 1024, 1024, 256, 4};
                    S.init(16 * 1024, 1024, F.G, F.G - 1 - F.bid); E = EpiScale{(bf16_t*)(ws + WS_VW), 1024, nullptr}; }
                pg8::gemm_phase<EpiScale, pg8::StaticOrder>(F.lds, g, S, E);
            }
        } else if (s == 3) {
            mixer_phase(F, l);
        } else {
            pg8::Gemm g{R1, (const bf16_t*)(ws + WS_KB) + (size_t)l * 2048 * 1024, 1024, 1024, 256, 1};
            pg8::StaticOrder S; S.init(MP, 1024, F.G, F.bid);
            EpiSoftmax E{R1};
            for (int pass = 0; pass < two; ++pass) {
                if ((pass == 0) == sgfirst) { for (int pr = F.G - 1 - F.bid; pr < 256; pr += F.G) sample_attn(F, l, pr); }
                if (pass == 0) pg8::gemm_phase<EpiSoftmax, pg8::StaticOrder>(F.lds, g, S, E);
            }
        }
        xcd_barrier(bar);
    }
    final_norm(F);
}

extern "C" void kernel_launch(void* const* d_in, const int* in_sizes, int n_in, void* d_out, int out_size, void* d_ws, size_t ws_size, hipStream_t stream) {
    static int grid = 0;
    if (grid == 0) {
        if (n_in != 22 || (size_t)out_size != O_END || ws_size < WS_END) { fprintf(stderr, "kernel_launch: unexpected sizes n_in %d out %d ws %zu (need %zu)\n", n_in, out_size, ws_size, (size_t)WS_END); grid = -1; return; }
        int dev = 0, cus = 0, per_cu = 0;
        if (hipGetDevice(&dev) != hipSuccess || hipDeviceGetAttribute(&cus, hipDeviceAttributeMultiprocessorCount, dev) != hipSuccess) { grid = -1; return; }
        if (hipFuncSetAttribute((const void*)fwd_kernel, hipFuncAttributeMaxDynamicSharedMemorySize, LDS_BYTES) != hipSuccess) { fprintf(stderr, "kernel_launch: hipFuncSetAttribute failed\n"); grid = -1; return; }
        if (hipOccupancyMaxActiveBlocksPerMultiprocessor(&per_cu, (const void*)fwd_kernel, 512, LDS_BYTES) != hipSuccess || per_cu < 1) { fprintf(stderr, "kernel_launch: occupancy query says %d\n", per_cu); per_cu = 1; }
        (void)hipGetLastError();
        grid = cus * 1;
    }
    if (grid < 0) return;
    if (hipMemsetAsync(d_ws, 0, 65536, stream) != hipSuccess) { fprintf(stderr, "kernel_launch: hipMemsetAsync failed\n"); return; }
    Args a{};
    for (int i = 0; i < 22; ++i) a.in[i] = (const float*)d_in[i];
    a.out = (float*)d_out; a.ws = (unsigned char*)d_ws;
    void* kargs[] = {&a};
    hipError_t e = hipLaunchCooperativeKernel((const void*)fwd_kernel, dim3(grid), dim3(512), kargs, LDS_BYTES, stream);
    if (e != hipSuccess) fprintf(stderr, "kernel_launch: cooperative launch failed: %s (grid %d)\n", hipGetErrorString(e), grid);
}
```

```cpp
#include <hip/hip_runtime.h>
#include <hip/hip_cooperative_groups.h>
#include <cstdio>
#include <cstdint>
namespace cg = cooperative_groups;

#define LAS __attribute__((address_space(3)))
typedef unsigned short bf16_t;
typedef short bf16x8 __attribute__((ext_vector_type(8)));
typedef float f32x4 __attribute__((ext_vector_type(4)));
typedef float f32x2 __attribute__((ext_vector_type(2)));
typedef unsigned u32x4 __attribute__((ext_vector_type(4)));
typedef unsigned u32x2 __attribute__((ext_vector_type(2)));

constexpr int D = 1024, SEQ = 4096, NB = 8, MP = NB * SEQ, MS = 256, MT = MP + MS, FF = 2816, DIN = 2048;
constexpr int NMEM = 256, NH = 4, HD = 256, SB = 16, SL = 16;
constexpr float EPS = 1e-6f;
constexpr float QSCALE = 0.0625f * 1.4426950408889634f;

constexpr size_t O_Y = 0, O_MK = (size_t)MT * D, O_MV = O_MK + (size_t)2 * 2048 * 1024, O_CSP = O_MV + (size_t)2 * 2048 * 1024,
                 O_PSP = O_CSP + 2 * 8 * 2 * 512, O_CSS = O_PSP + 2 * 8 * 15 * 512, O_PSS = O_CSS + 2 * 16 * 2 * 512, O_END = O_PSS + 2 * 16 * 15 * 512;

constexpr size_t MiB = 1u << 20;
constexpr size_t WS_SSQ = 1 * MiB, WS_RSM = 4 * MiB, WS_W = 8 * MiB;
constexpr size_t W_L = 43 * MiB;
constexpr size_t W_1 = 0, W_2 = 11 * MiB, W_1B = 33 * MiB / 2, W_2B = 55 * MiB / 2, W_M = 33 * MiB, W_O2 = 37 * MiB, W_Q = 39 * MiB, W_O = 41 * MiB;
constexpr size_t WS_WKV = WS_W + 2 * W_L;
constexpr size_t WS_XB = 102 * MiB, WS_R1 = 167 * MiB, WS_R2 = 345 * MiB, WS_MEMB = 410 * MiB, WS_KB = 414 * MiB, WS_VT = 422 * MiB, WS_VW = 430 * MiB, WS_END = 462 * MiB;
static_assert(W_1B == W_2 + (size_t)1024 * 2816 * 2 && W_2B == W_1B + 11 * MiB && W_2B + (size_t)1024 * 2816 * 2 == W_M, "weights map");
static_assert(WS_XB + (size_t)MT * D * 2 <= WS_R1 && WS_R1 + (size_t)MT * FF * 2 <= WS_R2 && WS_R2 + (size_t)MT * D * 2 <= WS_MEMB, "ws map");

constexpr int RING_BYTES = 131072, XCH_OFF = RING_BYTES + 1024, RS_OFF = XCH_OFF + 8192, LDS_BYTES = 147456;

__device__ __forceinline__ unsigned cvt_pk_bf16(float lo, float hi) { unsigned r; asm volatile("v_cvt_pk_bf16_f32 %0, %1, %2" : "=v"(r) : "v"(lo), "v"(hi)); return r; }
__device__ __forceinline__ float bf_lo(unsigned w) { return __uint_as_float(w << 16); }
__device__ __forceinline__ float bf_hi(unsigned w) { return __uint_as_float(w & 0xffff0000u); }
__device__ __forceinline__ float wave_sum(float v) {
#pragma unroll
    for (int o = 1; o < 64; o <<= 1) v += __shfl_xor(v, o);
    return v;
}
__device__ __forceinline__ float wave_max(float v) {
#pragma unroll
    for (int o = 1; o < 64; o <<= 1) v = fmaxf(v, __shfl_xor(v, o));
    return v;
}
__device__ __forceinline__ float row_rstd(const float* ssq, int row) {
    const f32x4* p = (const f32x4*)(ssq + (size_t)row * 16);
    const f32x4 a = p[0], b = p[1], c = p[2], d = p[3];
    const float s = (((a.x + a.y) + (a.z + a.w)) + ((b.x + b.y) + (b.z + b.w))) + (((c.x + c.y) + (c.z + c.w)) + ((d.x + d.y) + (d.z + d.w)));
    return rsqrtf(s * (1.0f / 1024.0f) + EPS);
}

struct RsLoad { f32x4 a0, b0, c0, d0, a1, b1, c1, d1; };
__device__ __forceinline__ void rs_issue(const float* ssq, int rbase, RsLoad& L) {
    const int lane = threadIdx.x & 63;
    const f32x4* p0 = (const f32x4*)(ssq + (size_t)(rbase + lane) * 16); const f32x4* p1 = (const f32x4*)(ssq + (size_t)(rbase + 128 + lane) * 16);
    L.a0 = p0[0]; L.b0 = p0[1]; L.c0 = p0[2]; L.d0 = p0[3]; L.a1 = p1[0]; L.b1 = p1[1]; L.c1 = p1[2]; L.d1 = p1[3];
    asm volatile("" ::: "memory");
}
__device__ __forceinline__ void rs_reduce(const RsLoad& L, float& r0, float& r1) {
    const f32x4 t0 = (L.a0 + L.b0) + (L.c0 + L.d0), t1 = (L.a1 + L.b1) + (L.c1 + L.d1);
    r0 = rsqrtf(((t0.x + t0.y) + (t0.z + t0.w)) * (1.0f / 1024.0f) + EPS); r1 = rsqrtf(((t1.x + t1.y) + (t1.z + t1.w)) * (1.0f / 1024.0f) + EPS);
}
__device__ __forceinline__ void rs_spread(float r0, float r1, int fr, float (&rs)[2][4]) {
#pragma unroll
    for (int m = 0; m < 4; ++m) { rs[0][m] = __shfl(r0, m * 16 + fr); rs[1][m] = __shfl(r1, m * 16 + fr); }
}

namespace pg8 {
constexpr int BM = 256, BK = 64, HALF = 128, HTB = HALF * BK * 2, NXCD = 8, WGM = 8;
__host__ __device__ __forceinline__ int lds_byte(int r, int c) { const int st = (r >> 4) * 2 + (c >> 5), rr = r & 15, cc = c & 31, ob = rr * 64 + cc * 2; return st * 1024 + (ob ^ (((ob >> 9) & 1) << 5)); }
__host__ __device__ __forceinline__ void stage_rc(int b, int& R, int& C) { const int st = b / 1024, sb = b % 1024, swz = sb ^ (((sb >> 9) & 1) << 5); R = (st >> 1) * 16 + swz / 64; C = (st & 1) * 32 + (swz % 64) / 2; }
__host__ __device__ __forceinline__ int perm32(int rho) { const int n = rho >> 4, i = rho & 15; return 8 * (i >> 2) + 4 * n + (i & 3); }

struct Unit { int pm, pn; };
struct Gemm { const bf16_t* A; const bf16_t* Bt; int lda, ldb, K, bmode; };
__device__ __forceinline__ size_t a_off(const Gemm& g, const Unit& u) {
    if (g.bmode == 4) return ((size_t)(u.pm & 3) * 256 * g.lda + (size_t)u.pn * 256) * 2 + (size_t)(u.pm >> 5) * W_L;
    size_t e = (size_t)u.pm * 256 * g.lda; if (g.bmode == 1 || g.bmode == 2) e += (size_t)u.pn * 256; return e * 2; }
__device__ __forceinline__ size_t b_off(const Gemm& g, const Unit& u) {
    if (g.bmode == 0) return (size_t)u.pn * 256 * g.ldb * 2;
    if (g.bmode == 1) return ((size_t)(u.pm >> 4) * 256 * g.ldb + (size_t)u.pn * 256) * 2;
    if (g.bmode == 2) return (size_t)((u.pm >> 4) * 4 + u.pn) * 65536 * 2;
    if (g.bmode == 3) return ((size_t)(u.pm >> 4) * 1024 * 1024 + (size_t)u.pn * 256 * 1024) * 2;
    return ((size_t)(u.pm >> 2) * 256 * g.ldb + (size_t)u.pn * 256) * 2;
}

struct StaticOrder {
    int nN, nig, q, step, off, gid, idx;
    __device__ void init(int M, int N, int G_, int c_) {
        const int nM = M / BM; nN = N / BM; nig = WGM * nN; const int nwg = nM * nN;
        if (G_ % NXCD == 0) { q = nwg / NXCD; step = G_ / NXCD; off = c_ / NXCD; const int w0 = (c_ % NXCD) * q + off; gid = w0 / nig; idx = w0 % nig; }
        else { q = nwg; step = G_; off = c_; gid = c_ / nig; idx = c_ % nig; }
    }
    __device__ bool next(int i, Unit& u) {
        if (i) { off += step; idx += step; while (idx >= nig) { idx -= nig; ++gid; } }
        if (off >= q) return false;
        u.pm = gid * WGM + (idx & (WGM - 1)); u.pn = idx >> 3; return true;
    }
};

template <class Epi, class Sched>
__device__ __forceinline__ void gemm_phase(LAS unsigned char* lds, const Gemm g, Sched S, const Epi& E) {
    int tid_ = threadIdx.x; asm volatile("" : "+v"(tid_));
    const int tid = tid_, wid = __builtin_amdgcn_readfirstlane(tid >> 6), lane = tid & 63, wr = wid >> 2, wc = wid & 3, fr = lane & 15, fq = lane >> 4;
    const int K = g.K, nt = K / BK;
    unsigned voffA[2], voffB[2];
#pragma unroll
    for (int i = 0; i < 2; ++i) { int R, C; stage_rc(tid * 16 + i * 8192, R, C); const int Rb = Epi::PERM ? ((R & ~31) + perm32(R & 31)) : R;
        voffA[i] = (unsigned)(R * g.lda + C) * 2u; voffB[i] = (unsigned)(Rb * g.ldb + C) * 2u; }
    const size_t kstep = (size_t)(BK * 2);
    const size_t hstepA = (size_t)HALF * g.lda * 2, hstepB = (size_t)HALF * g.ldb * 2;
    const unsigned ldsw = (unsigned)wid * 1024u;
    const int aoff = lds_byte(wr * 64 + fr, fq * 8), boff = lds_byte(wc * 32 + fr, fq * 8);
#define PG8_SA(b, h) (((b) * 2 + (h)) * HTB)
#define PG8_SB(b, h) ((4 + (b) * 2 + (h)) * HTB)
#define PG8_STAGE(bufoff, gbase, voff) do { _Pragma("unroll") for (int _i = 0; _i < 2; ++_i) \
        __builtin_amdgcn_global_load_lds((const unsigned*)((const char*)(gbase) + (voff)[_i]), (LAS unsigned*)(lds + (bufoff) + ldsw + _i * 8192), 16, 0, 0); } while (0)
#define PG8_LDA(dst, b, h) do { _Pragma("unroll") for (int m = 0; m < 4; ++m) _Pragma("unroll") for (int k = 0; k < 2; ++k) dst[m][k] = *(const LAS bf16x8*)(lds + PG8_SA(b, h) + aoff + m * 2048 + k * 1024); } while (0)
#define PG8_LDB(dst, b, h) do { _Pragma("unroll") for (int n = 0; n < 2; ++n) _Pragma("unroll") for (int k = 0; k < 2; ++k) dst[n][k] = *(const LAS bf16x8*)(lds + PG8_SB(b, h) + boff + n * 2048 + k * 1024); } while (0)
#define PG8_MMA(ai, bj, At, Bt) do { __builtin_amdgcn_s_setprio(1); _Pragma("unroll") for (int m = 0; m < 4; ++m) _Pragma("unroll") for (int n = 0; n < 2; ++n) _Pragma("unroll") for (int k = 0; k < 2; ++k) \
        acc[ai][bj][m][n] = __builtin_amdgcn_mfma_f32_16x16x32_bf16(Bt[n][k], At[m][k], acc[ai][bj][m][n], 0, 0, 0); __builtin_amdgcn_s_setprio(0); } while (0)
#define PG8_WAIT_V(n) asm volatile("s_waitcnt vmcnt(" #n ")" ::: "memory")
#define PG8_WAIT_L(n) asm volatile("s_waitcnt lgkmcnt(" #n ")" ::: "memory")
#define PG8_BAR __builtin_amdgcn_s_barrier()
#define PG8_SCHED __builtin_amdgcn_sched_barrier(0)
    Unit cur, nxt; int ui = 0;
    if (!S.next(0, cur)) return;
    f32x4 acc[2][2][4][2];
#pragma unroll
    for (int a = 0; a < 2; ++a)
#pragma unroll
        for (int b = 0; b < 2; ++b)
#pragma unroll
            for (int m = 0; m < 4; ++m)
#pragma unroll
                for (int n = 0; n < 2; ++n) acc[a][b][m][n] = (f32x4){0.f, 0.f, 0.f, 0.f};
    bf16x8 At[4][2], B0[2][2], B1[2][2];
    const char* cA = (const char*)g.A + a_off(g, cur); const char* cB = (const char*)g.Bt + b_off(g, cur);
    LAS float* rst = (LAS float*)(lds + RS_OFF) + wid * 128;
    if (Epi::NEEDS_RS && E.ssq) { RsLoad L; float r0, r1; rs_issue(E.ssq, cur.pm * 256 + wr * 64, L); rs_reduce(L, r0, r1); rst[lane] = r0; rst[64 + lane] = r1; }
    PG8_STAGE(PG8_SB(0, 0), cB, voffB); PG8_STAGE(PG8_SB(0, 1), cB + hstepB, voffB); PG8_STAGE(PG8_SA(0, 0), cA, voffA); PG8_STAGE(PG8_SA(0, 1), cA + hstepA, voffA);
    if (wr == 1) PG8_BAR;
    PG8_WAIT_V(2); PG8_BAR;
    PG8_STAGE(PG8_SB(1, 0), cB + kstep, voffB); PG8_STAGE(PG8_SA(1, 0), cA + kstep, voffA); PG8_STAGE(PG8_SB(1, 1), cB + hstepB + kstep, voffB);
    PG8_WAIT_V(6); PG8_BAR;
    for (;;) {
        const bool has_next = S.next(ui + 1, nxt);
        const char* nA = has_next ? (const char*)g.A + a_off(g, nxt) : cA; const char* nB = has_next ? (const char*)g.Bt + b_off(g, nxt) : cB;
        for (int t = 0; t < nt; t += 2) {
            const bool last = (t == nt - 2);
            const char* a1 = cA + (size_t)(t + 1) * kstep;
            const char* a2 = last ? nA : cA + (size_t)(t + 2) * kstep; const char* b2 = last ? nB : cB + (size_t)(t + 2) * kstep;
            const char* a3 = a2 + kstep; const char* b3 = b2 + kstep;
            PG8_LDB(B0, 0, 0); PG8_LDB(B1, 0, 1); PG8_SCHED; PG8_LDA(At, 0, 0); PG8_STAGE(PG8_SA(1, 1), a1 + hstepA, voffA);
            PG8_WAIT_V(8); PG8_WAIT_L(0); PG8_BAR; PG8_MMA(0, 0, At, B0); PG8_MMA(0, 1, At, B1); PG8_BAR; PG8_SCHED;
            PG8_LDA(At, 0, 1); PG8_STAGE(PG8_SB(0, 0), b2, voffB); PG8_STAGE(PG8_SB(0, 1), b2 + hstepB, voffB); PG8_STAGE(PG8_SA(0, 0), a2, voffA);
            PG8_WAIT_V(8); PG8_WAIT_L(0); PG8_BAR; PG8_MMA(1, 0, At, B0); PG8_MMA(1, 1, At, B1); PG8_BAR; PG8_SCHED;
            PG8_LDB(B0, 1, 0); PG8_LDB(B1, 1, 1); PG8_SCHED; PG8_LDA(At, 1, 0); PG8_STAGE(PG8_SA(0, 1), a2 + hstepA, voffA);
            PG8_WAIT_V(8); PG8_WAIT_L(0); PG8_BAR; PG8_MMA(0, 0, At, B0); PG8_MMA(0, 1, At, B1); PG8_BAR; PG8_SCHED;
            PG8_LDA(At, 1, 1); PG8_STAGE(PG8_SB(1, 0), b3, voffB); PG8_STAGE(PG8_SB(1, 1), b3 + hstepB, voffB); PG8_STAGE(PG8_SA(1, 0), a3, voffA);
            PG8_WAIT_V(8); PG8_WAIT_L(0); PG8_BAR; PG8_MMA(1, 0, At, B0); PG8_MMA(1, 1, At, B1); PG8_BAR; PG8_SCHED;
        }
        if (wr == 0) PG8_BAR;
        if (Epi::NEEDS_RS && E.ssq && has_next) {
            RsLoad L; float r0, r1; rs_issue(E.ssq, nxt.pm * 256 + wr * 64, L);
            E(acc, cur, wr, wc, fr, fq, lds, rst);
            rs_reduce(L, r0, r1); rst[lane] = r0; rst[64 + lane] = r1;
        } else E(acc, cur, wr, wc, fr, fq, lds, rst);
        if (!has_next) break;
#pragma unroll
        for (int a = 0; a < 2; ++a)
#pragma unroll
            for (int b = 0; b < 2; ++b)
#pragma unroll
                for (int m = 0; m < 4; ++m)
#pragma unroll
                    for (int n = 0; n < 2; ++n) acc[a][b][m][n] = (f32x4){0.f, 0.f, 0.f, 0.f};
        cur = nxt; cA = nA; cB = nB; ++ui;
        if (wr == 1) PG8_BAR;
    }
    PG8_WAIT_V(0);
    PG8_BAR;
#undef PG8_SA
#undef PG8_SB
#undef PG8_STAGE
#undef PG8_LDA
#undef PG8_LDB
#undef PG8_MMA
#undef PG8_WAIT_V
#undef PG8_WAIT_L
#undef PG8_BAR
#undef PG8_SCHED
}
}

using pg8::Unit;
typedef f32x4 Acc[2][2][4][2];

struct EpiSwiglu {
    static constexpr bool PERM = true, NEEDS_RS = true;
    bf16_t* O; const float* ssq;
    __device__ __forceinline__ void operator()(Acc& acc, const Unit& u, int wr, int wc, int fr, int fq, LAS unsigned char*, const LAS float* rst) const {
        const int row0 = u.pm * 256 + wr * 64 + fr, col0 = u.pn * 128 + wc * 32 + 8 * fq;
        float rsv[2][4];
#pragma unroll
        for (int m = 0; m < 4; ++m) { rsv[0][m] = rst[m * 16 + fr]; rsv[1][m] = rst[64 + m * 16 + fr]; }
#pragma unroll
        for (int ai = 0; ai < 2; ++ai)
#pragma unroll
            for (int m = 0; m < 4; ++m) {
                const int row = row0 + ai * 128 + m * 16; const float rs = rsv[ai][m];
                const float cexp = -1.4426950408889634f * rs, rs2 = rs * rs;
                unsigned w[4];
#pragma unroll
                for (int n = 0; n < 2; ++n)
#pragma unroll
                    for (int p = 0; p < 2; ++p) { const f32x2 g2 = {acc[ai][0][m][n][2 * p], acc[ai][0][m][n][2 * p + 1]}, u2 = {acc[ai][1][m][n][2 * p], acc[ai][1][m][n][2 * p + 1]};
                        f32x2 e2 = g2 * cexp; e2.x = __builtin_amdgcn_exp2f(e2.x); e2.y = __builtin_amdgcn_exp2f(e2.y);
                        const f32x2 d2 = e2 + 1.0f; f32x2 r2; r2.x = __builtin_amdgcn_rcpf(d2.x); r2.y = __builtin_amdgcn_rcpf(d2.y);
                        const f32x2 o2 = ((g2 * u2) * rs2) * r2; w[n * 2 + p] = cvt_pk_bf16(o2.x, o2.y); }
                *(u32x4*)(O + (size_t)row * FF + col0) = (u32x4){w[0], w[1], w[2], w[3]};
            }
    }
};
struct EpiScale {
    static constexpr bool PERM = true, NEEDS_RS = true;
    bf16_t* O; int ldc; const float* ssq;
    __device__ __forceinline__ void operator()(Acc& acc, const Unit& u, int wr, int wc, int fr, int fq, LAS unsigned char*, const LAS float* rst) const {
        const int row0 = u.pm * 256 + wr * 64 + fr, col0 = u.pn * 256 + wc * 32 + 8 * fq;
        float rsv[2][4];
#pragma unroll
        for (int m = 0; m < 4; ++m) { rsv[0][m] = ssq ? rst[m * 16 + fr] : 1.0f; rsv[1][m] = ssq ? rst[64 + m * 16 + fr] : 1.0f; }
#pragma unroll
        for (int ai = 0; ai < 2; ++ai)
#pragma unroll
            for (int m = 0; m < 4; ++m) {
                const int row = row0 + ai * 128 + m * 16; const float rs = rsv[ai][m];
#pragma unroll
                for (int bj = 0; bj < 2; ++bj) { const f32x4 v0 = acc[ai][bj][m][0] * rs, v1 = acc[ai][bj][m][1] * rs;
                    u32x4 w; w.x = cvt_pk_bf16(v0[0], v0[1]); w.y = cvt_pk_bf16(v0[2], v0[3]); w.z = cvt_pk_bf16(v1[0], v1[1]); w.w = cvt_pk_bf16(v1[2], v1[3]);
                    *(u32x4*)(O + (size_t)row * ldc + col0 + bj * 128) = w; }
            }
    }
};
struct EpiResid {
    static constexpr bool PERM = true, NEEDS_RS = false;
    bf16_t* XB; float* ssq; float scale;
    __device__ __forceinline__ void operator()(Acc& acc, const Unit& u, int wr, int wc, int fr, int fq, LAS unsigned char*, const LAS float* rst) const {
        const int row0 = u.pm * 256 + wr * 64 + fr, col0 = u.pn * 256 + wc * 32 + 8 * fq;
#pragma unroll
        for (int ai = 0; ai < 2; ++ai) {
            u32x4 xo[4][2];
#pragma unroll
            for (int m = 0; m < 4; ++m) { const size_t off = (size_t)(row0 + ai * 128 + m * 16) * D + col0;
#pragma unroll
                for (int bj = 0; bj < 2; ++bj) xo[m][bj] = *(const u32x4*)(XB + off + bj * 128); }
            asm volatile("" ::: "memory");
#pragma unroll
            for (int m = 0; m < 4; ++m) {
                const int row = row0 + ai * 128 + m * 16; const size_t off = (size_t)row * D + col0; float s = 0.f;
#pragma unroll
                for (int bj = 0; bj < 2; ++bj) { const f32x4 a0 = acc[ai][bj][m][0], a1 = acc[ai][bj][m][1]; const u32x4 o = xo[m][bj];
                    const float n0 = bf_lo(o.x) + a0[0] * scale, n1 = bf_hi(o.x) + a0[1] * scale, n2 = bf_lo(o.y) + a0[2] * scale, n3 = bf_hi(o.y) + a0[3] * scale;
                    const float n4 = bf_lo(o.z) + a1[0] * scale, n5 = bf_hi(o.z) + a1[1] * scale, n6 = bf_lo(o.w) + a1[2] * scale, n7 = bf_hi(o.w) + a1[3] * scale;
                    u32x4 w; w.x = cvt_pk_bf16(n0, n1); w.y = cvt_pk_bf16(n2, n3); w.z = cvt_pk_bf16(n4, n5); w.w = cvt_pk_bf16(n6, n7); *(u32x4*)(XB + off + bj * 128) = w;
                    s += ((n0 * n0 + n1 * n1) + (n2 * n2 + n3 * n3)) + ((n4 * n4 + n5 * n5) + (n6 * n6 + n7 * n7)); }
                s += __shfl_xor(s, 16); s += __shfl_xor(s, 32);
                if (fq == 0) ssq[(size_t)row * 16 + u.pn * 4 + wc] = s;
            }
            asm volatile("" ::: "memory");
        }
    }
};
struct EpiKV {
    static constexpr bool PERM = false, NEEDS_RS = false;
    float* dK; float* dV; bf16_t* Kb; bf16_t* Vt; const float* rsm; const float* ssq = nullptr;
    __device__ __forceinline__ void operator()(Acc& acc, const Unit& u, int wr, int wc, int fr, int fq, LAS unsigned char*, const LAS float* rst) const {
        const int l = u.pn >> 3, isV = (u.pn >> 2) & 1, h = u.pn & 3;
        const int row0 = u.pm * 256 + wr * 64 + fr, cc0 = h * 256 + wc * 32 + 4 * fq;
        float* dst = (isV ? dV : dK) + (size_t)l * 2048 * 1024;
#pragma unroll
        for (int ai = 0; ai < 2; ++ai)
#pragma unroll
            for (int m = 0; m < 4; ++m) {
                const int row = row0 + ai * 128 + m * 16; const float rs = rsm[row];
#pragma unroll
                for (int bj = 0; bj < 2; ++bj)
#pragma unroll
                    for (int n = 0; n < 2; ++n) { const f32x4 v = acc[ai][bj][m][n] * rs; const int cc = cc0 + bj * 128 + n * 16;
                        *(f32x4*)(dst + (size_t)row * 1024 + cc) = v;
                        if (!isV) { u32x2 w; w.x = cvt_pk_bf16(v[0], v[1]); w.y = cvt_pk_bf16(v[2], v[3]); *(u32x2*)(Kb + ((size_t)l * 2048 + row) * 1024 + cc) = w; }
                        else { u32x2 w; w.x = cvt_pk_bf16(v[0], v[1]); w.y = cvt_pk_bf16(v[2], v[3]); *(u32x2*)(Vt + ((size_t)l * 2048 + row) * 1024 + cc) = w; } }
            }
    }
};
struct EpiSoftmax {
    static constexpr bool PERM = true, NEEDS_RS = false;
    bf16_t* P; const float* ssq = nullptr;
    __device__ __forceinline__ void operator()(Acc& acc, const Unit& u, int wr, int wc, int fr, int fq, LAS unsigned char* lds, const LAS float* rst) const {
        unsigned xw = (unsigned)XCH_OFF + (unsigned)(((wr * 64 + fr) * 4 + wc) * 8), xr = (unsigned)XCH_OFF + (unsigned)((wr * 64 + fr) * 32);
        asm volatile("" : "+v"(xw), "+v"(xr));
        LAS f32x2* Xw = (LAS f32x2*)(lds + xw); const LAS f32x4* Xr = (const LAS f32x4*)(lds + xr);
#pragma unroll
        for (int ai = 0; ai < 2; ++ai)
#pragma unroll
            for (int m = 0; m < 4; ++m) {
                float mx = -INFINITY;
#pragma unroll
                for (int bj = 0; bj < 2; ++bj)
#pragma unroll
                    for (int n = 0; n < 2; ++n) { const f32x4 v = acc[ai][bj][m][n]; mx = fmaxf(mx, fmaxf(fmaxf(v[0], v[1]), fmaxf(v[2], v[3]))); }
                mx = fmaxf(mx, __shfl_xor(mx, 16)); mx = fmaxf(mx, __shfl_xor(mx, 32));
                float s = 0.f;
#pragma unroll
                for (int bj = 0; bj < 2; ++bj)
#pragma unroll
                    for (int n = 0; n < 2; ++n) { f32x4 v = acc[ai][bj][m][n];
#pragma unroll
                        for (int j = 0; j < 4; ++j) v[j] = __builtin_amdgcn_exp2f(v[j] - mx);
                        acc[ai][bj][m][n] = v; s += (v[0] + v[1]) + (v[2] + v[3]); }
                s += __shfl_xor(s, 16); s += __shfl_xor(s, 32);
                if (fq == 0) Xw[(ai * 128 + m * 16) * 4] = (f32x2){mx, s};
                asm volatile("" ::: "memory");
            }
        asm volatile("s_waitcnt lgkmcnt(0)" ::: "memory"); __builtin_amdgcn_s_barrier(); asm volatile("" ::: "memory");
        bf16_t* pb = P + (size_t)(u.pm * 256 + wr * 64 + fr) * D + (u.pn * 256 + wc * 32 + 8 * fq);
#pragma unroll
        for (int ai = 0; ai < 2; ++ai)
#pragma unroll
            for (int m = 0; m < 4; ++m) {
                const f32x4 p01 = Xr[(ai * 128 + m * 16) * 2], p23 = Xr[(ai * 128 + m * 16) * 2 + 1];
                const float M = fmaxf(fmaxf(p01.x, p01.z), fmaxf(p23.x, p23.z));
                const float tot = (p01.y * __builtin_amdgcn_exp2f(p01.x - M) + p01.w * __builtin_amdgcn_exp2f(p01.z - M)) + (p23.y * __builtin_amdgcn_exp2f(p23.x - M) + p23.w * __builtin_amdgcn_exp2f(p23.z - M));
                const float mine = wc == 0 ? p01.x : wc == 1 ? p01.z : wc == 2 ? p23.x : p23.z;
                const float f = __builtin_amdgcn_exp2f(mine - M) / tot;
                bf16_t* rp = pb + (size_t)(ai * 128 + m * 16) * D;
#pragma unroll
                for (int bj = 0; bj < 2; ++bj) { const f32x4 v0 = acc[ai][bj][m][0] * f, v1 = acc[ai][bj][m][1] * f;
                    u32x4 w; w.x = cvt_pk_bf16(v0[0], v0[1]); w.y = cvt_pk_bf16(v0[2], v0[3]); w.z = cvt_pk_bf16(v1[0], v1[1]); w.w = cvt_pk_bf16(v1[2], v1[3]);
                    *(u32x4*)(rp + bj * 128) = w; }
                asm volatile("" ::: "memory");
            }
    }
};

typedef float f32x16 __attribute__((ext_vector_type(16)));
struct SgArgs { const bf16_t* A; int lda; const bf16_t* Bt; int ldb, K; const float* ssq_in; bf16_t* O; int ldc; float* X; bf16_t* XB; float* ssq_out; float scale; };
template <int MODE>
__device__ __forceinline__ void sgemm_phase(LAS unsigned char* lds, const SgArgs g, int ntiles, int bid, int G) {
    int tid = threadIdx.x; asm volatile("" : "+v"(tid)); const int lane = tid & 63, wave = __builtin_amdgcn_readfirstlane(tid >> 6);
    const int r32 = lane & 31, hi = lane >> 5, kw = g.K >> 3;
    for (int t = bid; t < ntiles; t += G) {
        const int ct = t >> 3, rt = t & 7;
        const int brow0 = MODE == 0 ? 256 * (ct >> 2) + 32 * (ct & 3) : 64 * ct, brow1 = MODE == 0 ? brow0 + 128 : brow0 + 32;
        const bf16_t* ap = g.A + (size_t)(MP + rt * 32 + r32) * g.lda + wave * kw + hi * 8;
        const bf16_t* bp0 = g.Bt + (size_t)(brow0 + r32) * g.ldb + wave * kw + hi * 8;
        const bf16_t* bp1 = g.Bt + (size_t)(brow1 + r32) * g.ldb + wave * kw + hi * 8;
        f32x16 c0 = {}, c1 = {};
        for (int k0 = 0; k0 < kw; k0 += 128) {
            bf16x8 a[8], b0[8], b1[8];
#pragma unroll
            for (int i = 0; i < 8; ++i) if (k0 + 16 * i < kw) { a[i] = *(const bf16x8*)(ap + k0 + 16 * i); b0[i] = *(const bf16x8*)(bp0 + k0 + 16 * i); b1[i] = *(const bf16x8*)(bp1 + k0 + 16 * i); }
            asm volatile("" ::: "memory");
#pragma unroll
            for (int i = 0; i < 8; ++i) if (k0 + 16 * i < kw) { c0 = __builtin_amdgcn_mfma_f32_32x32x16_bf16(a[i], b0[i], c0, 0, 0, 0); c1 = __builtin_amdgcn_mfma_f32_32x32x16_bf16(a[i], b1[i], c1, 0, 0, 0); }
        }
        LAS float* red = (LAS float*)lds + wave * 2048;
#pragma unroll
        for (int r = 0; r < 16; ++r) { const int row = (r & 3) + 8 * (r >> 2) + 4 * hi; red[row * 64 + r32] = c0[r]; red[row * 64 + 32 + r32] = c1[r]; }
        __syncthreads();
        const int row = tid >> 4, q = tid & 15; float v0 = 0.f, v1 = 0.f, v2 = 0.f, v3 = 0.f;
#pragma unroll
        for (int w = 0; w < 8; ++w) { const LAS float* p = (const LAS float*)lds + w * 2048 + row * 64 + 2 * q; const f32x2 lo = *(const LAS f32x2*)p, hi2 = *(const LAS f32x2*)(p + 32); v0 += lo.x; v1 += lo.y; v2 += hi2.x; v3 += hi2.y; }
        const int grow = MP + rt * 32 + row;
        if (MODE == 0) {
            const float rs = row_rstd(g.ssq_in, grow); const float g0 = v0 * rs, g1 = v1 * rs, u0 = v2 * rs, u1 = v3 * rs;
            const float a0 = g0 * __builtin_amdgcn_rcpf(1.0f + __builtin_amdgcn_exp2f(-1.4426950408889634f * g0)) * u0, a1 = g1 * __builtin_amdgcn_rcpf(1.0f + __builtin_amdgcn_exp2f(-1.4426950408889634f * g1)) * u1;
            *(unsigned*)(g.O + (size_t)grow * g.ldc + 128 * (ct >> 2) + 32 * (ct & 3) + 2 * q) = cvt_pk_bf16(a0, a1);
        } else if (MODE == 1) {
            const float rs = row_rstd(g.ssq_in, grow); bf16_t* op = g.O + (size_t)grow * g.ldc + 64 * ct + 2 * q;
            *(unsigned*)op = cvt_pk_bf16(v0 * rs, v1 * rs); *(unsigned*)(op + 32) = cvt_pk_bf16(v2 * rs, v3 * rs);
        } else {
            const size_t off = (size_t)grow * D + 64 * ct + 2 * q;
            const unsigned xa = *(const unsigned*)(g.XB + off), xb = *(const unsigned*)(g.XB + off + 32);
            const float n0 = bf_lo(xa) + g.scale * v0, n1 = bf_hi(xa) + g.scale * v1, n2 = bf_lo(xb) + g.scale * v2, n3 = bf_hi(xb) + g.scale * v3;
            *(unsigned*)(g.XB + off) = cvt_pk_bf16(n0, n1); *(unsigned*)(g.XB + off + 32) = cvt_pk_bf16(n2, n3);
            float ss = (n0 * n0 + n1 * n1) + (n2 * n2 + n3 * n3);
            ss += __shfl_xor(ss, 1); ss += __shfl_xor(ss, 2); ss += __shfl_xor(ss, 4); ss += __shfl_xor(ss, 8);
            if (q == 0) g.ssq_out[(size_t)grow * 16 + ct] = ss;
        }
        __syncthreads();
    }
}

#define XB_TMO      128
#define XB_XCNT(j)  (256  + 64 * (j))
#define XB_XSUB(j)  (1280 + 64 * (j))
#define XB_XGEN(j)  (2304 + 64 * (j))
#define XB_TOP      3328
#define XB_TOPGEN   3392
#define XCD_BAR_WORDS 3456
#define XB_SPIN_CAP (1u << 18)
__device__ __forceinline__ unsigned xb_ld(unsigned* p)              { return __hip_atomic_load(p, __ATOMIC_RELAXED, __HIP_MEMORY_SCOPE_AGENT); }
__device__ __forceinline__ unsigned xb_add(unsigned* p, unsigned v) { return __hip_atomic_fetch_add(p, v, __ATOMIC_RELAXED, __HIP_MEMORY_SCOPE_AGENT); }
__device__ __forceinline__ unsigned xb_xcc_id() { return (unsigned)__builtin_amdgcn_s_getreg((3 << 11) | 20) & 0xFu; }
#define XB_SPIN(cond, bar) do { unsigned _sp = 0; while (cond) { __builtin_amdgcn_s_sleep(1); \
    if ((++_sp & 255u) == 0u) { if (xb_ld(&(bar)[XB_TMO])) break; if (_sp > XB_SPIN_CAP) { atomicAdd(&(bar)[XB_TMO], 1u); break; } } } } while (0)
struct XcdBarrier { unsigned* bar; unsigned x; volatile LAS unsigned* st; };
__device__ __forceinline__ XcdBarrier xcd_barrier_post(unsigned* bar, volatile LAS unsigned* st) {
    XcdBarrier b; b.bar = bar; b.x = xb_xcc_id(); b.st = st;
    if (threadIdx.x == 0) (void)xb_add(&bar[XB_XCNT(b.x)], 1u);
    return b;
}
__device__ __forceinline__ void xcd_barrier_complete(unsigned* bar, unsigned x, unsigned& nloc, unsigned& nx) {
    const unsigned G = gridDim.x * gridDim.y * gridDim.z;
    unsigned sum, cnt, mine, sp = 0u;
    for (;;) {
        sum = 0u; cnt = 0u; mine = 0u;
#pragma unroll
        for (unsigned j = 0; j < 16; ++j) { const unsigned c = xb_ld(&bar[XB_XCNT(j)]); sum += c; cnt += (c > 0u) ? 1u : 0u; mine = (j == x) ? c : mine; }
        if (sum == G) break;
        __builtin_amdgcn_s_sleep(1);
        if ((++sp & 255u) == 0u) { if (xb_ld(&bar[XB_TMO])) break; if (sp > XB_SPIN_CAP) { atomicAdd(&bar[XB_TMO], 1u); break; } }
    }
    nloc = mine > 0u ? mine : 1u; nx = cnt > 0u ? cnt : 1u;
}
__device__ __forceinline__ void xcd_barrier(const XcdBarrier& b) {
    asm volatile("s_waitcnt vmcnt(0)" ::: "memory");
    __syncthreads();
    if (threadIdx.x == 0) {
        unsigned* bar = b.bar; asm volatile("" : "+s"(bar));
        __builtin_amdgcn_s_waitcnt(0);
        const unsigned bx = xb_xcc_id();
        unsigned nloc = b.st[0], nx = b.st[1];
        if (nloc == 0u) { xcd_barrier_complete(bar, bx, nloc, nx); b.st[0] = nloc; b.st[1] = nx; }
        const unsigned old = xb_add(&bar[XB_XSUB(bx)], 1u);
        const unsigned gen = old / nloc;
        if (old + 1u == (gen + 1u) * nloc) {
            __builtin_amdgcn_fence(__ATOMIC_RELEASE, "agent");
            asm volatile("s_waitcnt vmcnt(0)" ::: "memory");
            const unsigned og = xb_add(&bar[XB_TOP], 1u);
            const unsigned tg = og / nx;
            if (og + 1u == (tg + 1u) * nx) xb_add(&bar[XB_TOPGEN], 1u);
            else XB_SPIN(xb_ld(&bar[XB_TOPGEN]) == tg, bar);
            __builtin_amdgcn_fence(__ATOMIC_ACQUIRE, "agent");
            xb_add(&bar[XB_XGEN(bx)], 1u);
            asm volatile("s_waitcnt vmcnt(0)" ::: "memory");
        } else {
            XB_SPIN(xb_ld(&bar[XB_XGEN(bx)]) == gen, bar);
            __builtin_amdgcn_fence(__ATOMIC_ACQUIRE, "agent");
            asm volatile("s_waitcnt vmcnt(0)" ::: "memory");
        }
    }
    __syncthreads();
}

__device__ __forceinline__ SgArgs sa_dummy(const bf16_t* A, const bf16_t* Bt, const float* ssq, bf16_t* O, int ldc) { return SgArgs{A, 1024, Bt, 1024, 1024, ssq, O, ldc, nullptr, nullptr, nullptr, 0.f}; }

struct Args { const float* in[22]; float* out; unsigned char* ws; };
struct Frame {
    LAS unsigned char* lds; int G, bid;
    const float* const* in; float* out; unsigned char* ws;
};

__device__ __forceinline__ void transpose_item(const float* W, int N, const float* gain, float scale, bf16_t* WT, int ldk, int drow0, int k0, int n0, LAS float* scr, int lane) {
    float tv[32];
    const float* wp = W + (size_t)(k0 + (lane >> 5)) * N + n0 + (lane & 31);
#pragma unroll
    for (int i = 0; i < 32; ++i) tv[i] = wp[(size_t)(2 * i) * N];
#pragma unroll
    for (int i = 0; i < 32; ++i) { const int kk = 2 * i + (lane >> 5); const float gv = gain ? gain[k0 + kk] * scale : scale;
        scr[kk * 33 + (lane & 31)] = tv[i] * gv; }
    asm volatile("s_waitcnt lgkmcnt(0)" ::: "memory");
    const int c = lane & 7;
#pragma unroll
    for (int j = 0; j < 4; ++j) { const int n = (lane >> 3) + 8 * j; const LAS float* s = scr + (8 * c) * 33 + n;
        u32x4 o; o.x = cvt_pk_bf16(s[0 * 33], s[1 * 33]); o.y = cvt_pk_bf16(s[2 * 33], s[3 * 33]); o.z = cvt_pk_bf16(s[4 * 33], s[5 * 33]); o.w = cvt_pk_bf16(s[6 * 33], s[7 * 33]);
        *(u32x4*)(WT + (size_t)(drow0 + n) * ldk + k0 + 8 * c) = o; }
    asm volatile("s_waitcnt lgkmcnt(0)" ::: "memory");
}

constexpr int TI_1 = 2816, TI_3 = 1408, TI_5 = 1024, TI_6 = 256, TI_7 = 512, TI_9 = 1024;
constexpr int TI_L = 2 * TI_1 + 2 * TI_3 + TI_5 + TI_6 + 2 * TI_7 + TI_9;
constexpr int N_TR = 2 * TI_L, N_WC = 2048, N_XR = MT, N_MR = 2048, N_P0 = N_TR + N_WC + N_XR + N_MR;

__device__ __forceinline__ void prologue(Frame& F) {
    int tid = threadIdx.x; asm volatile("" : "+v"(tid)); const int lane = tid & 63, wave = __builtin_amdgcn_readfirstlane(tid >> 6); (void)lane; (void)wave;
    LAS float* scr = (LAS float*)(F.lds + wave * 16384);
    const int gw = F.bid * 8 + wave, NGW = F.G * 8;
    unsigned char* ws = F.ws;
    for (int it = gw; it < N_TR + N_WC; it += NGW) {
        if (it < N_TR) {
            const int l = it / TI_L; int r = it % TI_L;
            unsigned char* wl = ws + WS_W + (size_t)l * W_L;
            const float* W; const float* gain = nullptr; float scale = 1.f; bf16_t* dst; int N, ldk, mode = 0;
            if (r < 2 * TI_1) { const int j = r / TI_1; r %= TI_1; W = F.in[8] + (size_t)(l * 2 + j) * 1024 * 5632; gain = F.in[7] + (l * 2 + j) * 1024; dst = (bf16_t*)(wl + (j ? W_1B : W_1)); N = 5632; ldk = 1024; mode = 1; }
            else if ((r -= 2 * TI_1) < 2 * TI_3) { const int j = r / TI_3; r %= TI_3; W = F.in[9] + (size_t)(l * 2 + j) * 2816 * 1024; dst = (bf16_t*)(wl + (j ? W_2B : W_2)); N = 1024; ldk = 2816; }
            else if ((r -= 2 * TI_3) < TI_5) { W = F.in[11] + (size_t)l * 1024 * 2048; gain = F.in[10] + l * 1024; dst = (bf16_t*)(wl + W_M); N = 2048; ldk = 1024; }
            else if ((r -= TI_5) < TI_6) { W = F.in[15] + (size_t)l * 1024 * 1024; dst = (bf16_t*)(wl + W_O2); N = 1024; ldk = 1024; }
            else if ((r -= TI_6) < TI_7) { W = F.in[18] + (size_t)l * 1024 * 1024; gain = F.in[16] + l * 1024; scale = QSCALE; dst = (bf16_t*)(wl + W_Q); N = 1024; ldk = 1024; }
            else if ((r -= TI_7) < TI_7) { W = F.in[20] + (size_t)l * 1024 * 1024; dst = (bf16_t*)(wl + W_O); N = 1024; ldk = 1024; }
            else { r -= TI_7; W = F.in[19] + (size_t)l * 1024 * 2048; gain = F.in[17] + l * 1024; dst = (bf16_t*)(ws + WS_WKV) + (size_t)l * 2048 * 1024; N = 2048; ldk = 1024; }
            const int nblk = N / 32, kb = r / nblk, nb = r % nblk, k0 = kb * 64, n0 = nb * 32;
            int drow0 = n0;
            if (mode == 1) { const int isu = n0 >= FF ? 1 : 0, i0 = n0 - isu * FF; drow0 = (i0 >> 7) * 256 + isu * 128 + (i0 & 127); }
            transpose_item(W, N, gain, scale, dst, ldk, drow0, k0, n0, scr, lane);
        } else {
            const int wi = it - N_TR, l = wi >> 10, r = wi & 1023, g = r >> 8, co = (r >> 4) & 15, nb = r & 15, n = nb * 64 + lane, c0 = co * 8;
            const float* wo = F.in[15] + (size_t)l * 1024 * 1024 + (size_t)(512 + g * 128) * 1024 + n;
            const float* ps = F.in[14] + l * 512 + g * 128;
            const float* pw = F.in[13] + (size_t)((l * 4 + g) * 128 + c0) * 128;
            float a[8];
#pragma unroll
            for (int i = 0; i < 8; ++i) a[i] = 0.f;
#pragma unroll 16
            for (int d = 0; d < 128; ++d) { const float w = wo[(size_t)d * 1024] * ps[d];
#pragma unroll
                for (int i = 0; i < 8; ++i) a[i] += pw[i * 128 + d] * w; }
            bf16_t* dst = (bf16_t*)(ws + WS_W + (size_t)l * W_L + W_O2) + (size_t)n * 1024 + 512 + g * 128 + c0;
            u32x4 o; o.x = cvt_pk_bf16(a[0], a[1]); o.y = cvt_pk_bf16(a[2], a[3]); o.z = cvt_pk_bf16(a[4], a[5]); o.w = cvt_pk_bf16(a[6], a[7]);
            *(u32x4*)dst = o;
        }
    }
    for (int m0 = gw; m0 < MT; m0 += 4 * NGW) {
        f32x4 v[4][4];
#pragma unroll
        for (int r = 0; r < 4; ++r) { const int m = m0 + r * NGW; if (m < MT) { const float* src = m < MP ? F.in[0] + (size_t)m * D : F.in[1] + (size_t)(m - MP) * D; const f32x4* xr = (const f32x4*)src + lane;
#pragma unroll
            for (int j = 0; j < 4; ++j) v[r][j] = xr[64 * j]; } }
#pragma unroll
        for (int r = 0; r < 4; ++r) { const int m = m0 + r * NGW; if (m < MT) { float s = 0.f;
#pragma unroll
            for (int j = 0; j < 4; ++j) s += (v[r][j].x * v[r][j].x + v[r][j].y * v[r][j].y) + (v[r][j].z * v[r][j].z + v[r][j].w * v[r][j].w);
            s = wave_sum(s);
            u32x2* xb = (u32x2*)((bf16_t*)(ws + WS_XB) + (size_t)m * D) + lane;
#pragma unroll
            for (int j = 0; j < 4; ++j) { u32x2 w; w.x = cvt_pk_bf16(v[r][j].x, v[r][j].y); w.y = cvt_pk_bf16(v[r][j].z, v[r][j].w); xb[64 * j] = w; }
            if (lane < 16) ((float*)(ws + WS_SSQ))[(size_t)m * 16 + lane] = lane == 0 ? s : 0.f; } }
    }
    for (int m = gw; m < N_MR; m += NGW) {
        const f32x4* xr = (const f32x4*)(F.in[2] + (size_t)m * D) + lane; f32x4 v[4]; float s = 0.f;
#pragma unroll
        for (int j = 0; j < 4; ++j) { v[j] = xr[64 * j]; s += (v[j].x * v[j].x + v[j].y * v[j].y) + (v[j].z * v[j].z + v[j].w * v[j].w); }
        s = wave_sum(s);
        u32x2* xb = (u32x2*)((bf16_t*)(ws + WS_MEMB) + (size_t)m * D) + lane;
#pragma unroll
        for (int j = 0; j < 4; ++j) { u32x2 w; w.x = cvt_pk_bf16(v[j].x, v[j].y); w.y = cvt_pk_bf16(v[j].z, v[j].w); xb[64 * j] = w; }
        if (lane == 0) ((float*)(ws + WS_RSM))[m] = rsqrtf(s * (1.0f / 1024.0f) + EPS);
    }
}

__device__ __forceinline__ void ld8(const bf16_t* p, float (&o)[8]) { const u32x4 w = *(const u32x4*)p;
    o[0] = bf_lo(w.x); o[1] = bf_hi(w.x); o[2] = bf_lo(w.y); o[3] = bf_hi(w.y); o[4] = bf_lo(w.z); o[5] = bf_hi(w.z); o[6] = bf_lo(w.w); o[7] = bf_hi(w.w); }
__device__ __forceinline__ void up8(const u32x4 w, float (&o)[8]) {
    o[0] = bf_lo(w.x); o[1] = bf_hi(w.x); o[2] = bf_lo(w.y); o[3] = bf_hi(w.y); o[4] = bf_lo(w.z); o[5] = bf_hi(w.z); o[6] = bf_lo(w.w); o[7] = bf_hi(w.w); }
__device__ __forceinline__ void ld8f(const float* p, float (&o)[8]) { const f32x4 a = *(const f32x4*)p, b = *(const f32x4*)(p + 4);
    o[0] = a.x; o[1] = a.y; o[2] = a.z; o[3] = a.w; o[4] = b.x; o[5] = b.y; o[6] = b.z; o[7] = b.w; }
__device__ __forceinline__ void st8(bf16_t* p, const float (&o)[8]) { u32x4 w; w.x = cvt_pk_bf16(o[0], o[1]); w.y = cvt_pk_bf16(o[2], o[3]); w.z = cvt_pk_bf16(o[4], o[5]); w.w = cvt_pk_bf16(o[6], o[7]); *(u32x4*)p = w; }
__device__ __forceinline__ void st8f(float* p, const float (&o)[8]) { *(f32x4*)p = (f32x4){o[0], o[1], o[2], o[3]}; *(f32x4*)(p + 4) = (f32x4){o[4], o[5], o[6], o[7]}; }

__device__ __forceinline__ void mixer_phase(Frame& F, int l) {
    const bf16_t* Z = (const bf16_t*)(F.ws + WS_R1); bf16_t* A2 = (bf16_t*)(F.ws + WS_R2);
    int tid = threadIdx.x; asm volatile("" : "+v"(tid)); const int lane = tid & 63, wave = __builtin_amdgcn_readfirstlane(tid >> 6); (void)lane; (void)wave;
    constexpr int NPI = 8 * 128 * 128, NSI = 16 * 128;
    for (int it = F.bid * 512 + tid; it < NPI + NSI; it += F.G * 512) {
        const bool samp = it >= NPI; int oct, s, t0, T; size_t rowbase;
        if (!samp) { oct = it & 127; t0 = ((it >> 7) & 127) * 32; s = it >> 14; T = 32; rowbase = (size_t)s * SEQ; }
        else { const int j = it - NPI; oct = j & 127; s = j >> 7; t0 = 0; T = 16; rowbase = (size_t)MP + s * SL; }
        const bool lastchunk = samp || (t0 + T == SEQ);
        if (oct < 64) {
            const int c0 = oct * 8;
            float w0[8], w1[8], w2[8], cv1[8], cv2[8];
            ld8f(F.in[12] + (size_t)(l * 3 + 0) * 512 + c0, w0); ld8f(F.in[12] + (size_t)(l * 3 + 1) * 512 + c0, w1); ld8f(F.in[12] + (size_t)(l * 3 + 2) * 512 + c0, w2);
            if (t0 >= 2) { float c[8], v[8]; const bf16_t* zr = Z + (rowbase + t0 - 2) * DIN; ld8(zr + 512 + c0, c); ld8(zr + 1024 + c0, v);
#pragma unroll
                for (int i = 0; i < 8; ++i) cv2[i] = c[i] * v[i];
                zr += DIN; ld8(zr + 512 + c0, c); ld8(zr + 1024 + c0, v);
#pragma unroll
                for (int i = 0; i < 8; ++i) cv1[i] = c[i] * v[i]; }
            else if (samp) { const float* st = F.in[5] + (size_t)((l * 16 + s) * 2) * 512 + c0; ld8f(st, cv2); ld8f(st + 512, cv1); }
            else {
#pragma unroll
                for (int i = 0; i < 8; ++i) { cv1[i] = 0.f; cv2[i] = 0.f; } }
            float* cst = F.out + (samp ? O_CSS + (size_t)((l * 16 + s) * 2) * 512 : O_CSP + (size_t)((l * 8 + s) * 2) * 512) + c0;
            for (int t4 = t0; t4 < t0 + T; t4 += 4) {
                u32x4 rb[4], rc[4], rv[4];
#pragma unroll
                for (int k = 0; k < 4; ++k) { const bf16_t* zr = Z + (rowbase + t4 + k) * DIN + c0; rb[k] = *(const u32x4*)zr; rc[k] = *(const u32x4*)(zr + 512); rv[k] = *(const u32x4*)(zr + 1024); }
#pragma unroll
                for (int k = 0; k < 4; ++k) { const int t = t4 + k; float b[8], c[8], v[8], y[8]; up8(rb[k], b); up8(rc[k], c); up8(rv[k], v);
#pragma unroll
                    for (int i = 0; i < 8; ++i) { const float cv = c[i] * v[i]; y[i] = b[i] * (w0[i] * cv2[i] + w1[i] * cv1[i] + w2[i] * cv); cv2[i] = cv1[i]; cv1[i] = cv; }
                    st8(A2 + (rowbase + t) * D + c0, y);
                    if (lastchunk && t >= t0 + T - 2) st8f(cst + (size_t)(t - (t0 + T - 2)) * 512, cv1); }
            }
        } else {
            const int po = oct - 64, c0 = po * 8, g = po >> 4, w = 2 << g;
            float S[8];
#pragma unroll
            for (int i = 0; i < 8; ++i) S[i] = 0.f;
            const float* pst = F.in[6] + (size_t)((l * 16 + s) * 15) * 512 + c0;
            if (samp || t0 > 0) {
#pragma unroll
                for (int k = 1; k < 16; ++k) { float p[8];
                    if (samp) ld8f(pst + (size_t)(15 - k) * 512, p); else ld8(Z + (rowbase + t0 - k) * DIN + 1536 + c0, p);
                    const float mk = k < w ? 1.0f : 0.0f;
#pragma unroll
                    for (int i = 0; i < 8; ++i) S[i] += mk * p[i]; }
            }
            float* pso = F.out + (samp ? O_PSS + (size_t)((l * 16 + s) * 15) * 512 : O_PSP + (size_t)((l * 8 + s) * 15) * 512) + c0;
            if (!samp) {
                for (int t4 = t0; t4 < t0 + T; t4 += 4) {
                    u32x4 rp[4], rq[4];
#pragma unroll
                    for (int k = 0; k < 4; ++k) { const int t = t4 + k, tp = t - w + 1; rp[k] = *(const u32x4*)(Z + (rowbase + t) * DIN + 1536 + c0);
                        rq[k] = tp >= 0 ? *(const u32x4*)(Z + (rowbase + tp) * DIN + 1536 + c0) : (u32x4){0u, 0u, 0u, 0u}; }
#pragma unroll
                    for (int k = 0; k < 4; ++k) { const int t = t4 + k; float p[8], q[8], y[8]; up8(rp[k], p); up8(rq[k], q);
                        const int cn = (t + 1 < w) ? t + 1 : w; const float ic = 1.0f / (float)cn;
#pragma unroll
                        for (int i = 0; i < 8; ++i) { S[i] += p[i]; y[i] = S[i] * ic - p[i]; S[i] -= q[i]; }
                        st8(A2 + (rowbase + t) * D + 512 + c0, y);
                        if (lastchunk && t >= t0 + T - 15) st8f(pso + (size_t)(t - (t0 + T - 15)) * 512, p); }
                }
            } else {
                for (int t4 = 0; t4 < 16; t4 += 4) {
                    u32x4 rp[4], rq[4]; f32x4 sa[4], sb[4];
#pragma unroll
                    for (int k = 0; k < 4; ++k) { const int t = t4 + k, tp = t - w + 1, tz = tp < 0 ? 0 : tp, ts = tp < 0 ? 15 + tp : 0;
                        rp[k] = *(const u32x4*)(Z + (rowbase + t) * DIN + 1536 + c0); rq[k] = *(const u32x4*)(Z + (rowbase + tz) * DIN + 1536 + c0);
                        sa[k] = *(const f32x4*)(pst + (size_t)ts * 512); sb[k] = *(const f32x4*)(pst + (size_t)ts * 512 + 4); }
#pragma unroll
                    for (int k = 0; k < 4; ++k) { const int t = t4 + k, tp = t - w + 1; float p[8], q[8], y[8]; up8(rp[k], p); up8(rq[k], q);
                        if (tp < 0) { q[0] = sa[k].x; q[1] = sa[k].y; q[2] = sa[k].z; q[3] = sa[k].w; q[4] = sb[k].x; q[5] = sb[k].y; q[6] = sb[k].z; q[7] = sb[k].w; }
                        const float ic = 1.0f / (float)w;
#pragma unroll
                        for (int i = 0; i < 8; ++i) { S[i] += p[i]; y[i] = S[i] * ic - p[i]; S[i] -= q[i]; }
                        st8(A2 + (rowbase + t) * D + 512 + c0, y);
                        if (t >= 1) st8f(pso + (size_t)(t - 1) * 512, p); }
                }
            }
        }
    }
}

__device__ __forceinline__ void sample_attn(Frame& F, int l, int item) {
    int tid = threadIdx.x; asm volatile("" : "+v"(tid)); const int lane = tid & 63, wave = __builtin_amdgcn_readfirstlane(tid >> 6); (void)lane; (void)wave;
    const int pair = item >> 2, dq = item & 3, b = pair >> 2, h = pair & 3, w = wave;
    constexpr int SP = 260;
    LAS float* Ssm = (LAS float*)F.lds;
    bf16_t* Q = (bf16_t*)(F.ws + WS_R1);
    const float* CK = F.in[3] + (size_t)(l * 16 + b) * 256 * 1024 + h * 256;
    const float* CV = F.in[4] + (size_t)(l * 16 + b) * 256 * 1024 + h * 256;
    const int r16 = lane & 15, quad = lane >> 4;
    const bf16_t* qp = Q + (size_t)(MP + b * 16 + r16) * D + h * 256 + quad * 8;
#pragma unroll
    for (int kk = 0; kk < 2; ++kk) {
        const int kt = 2 * w + kk; const float* kp = CK + (size_t)(kt * 16 + r16) * 1024 + quad * 8;
        f32x4 acc = (f32x4){0.f, 0.f, 0.f, 0.f};
#pragma unroll
        for (int c = 0; c < 8; ++c) { const bf16x8 a = *(const bf16x8*)(qp + 32 * c); const f32x4 k0 = *(const f32x4*)(kp + 32 * c), k1 = *(const f32x4*)(kp + 32 * c + 4);
            u32x4 kb; kb.x = cvt_pk_bf16(k0.x, k0.y); kb.y = cvt_pk_bf16(k0.z, k0.w); kb.z = cvt_pk_bf16(k1.x, k1.y); kb.w = cvt_pk_bf16(k1.z, k1.w);
            acc = __builtin_amdgcn_mfma_f32_16x16x32_bf16(a, __builtin_bit_cast(bf16x8, kb), acc, 0, 0, 0); }
#pragma unroll
        for (int j = 0; j < 4; ++j) Ssm[(quad * 4 + j) * SP + kt * 16 + r16] = acc[j];
    }
    __syncthreads();
#pragma unroll
    for (int rr = 0; rr < 2; ++rr) { const int r = 2 * w + rr; f32x4 v = *(LAS f32x4*)(Ssm + r * SP + 4 * lane);
        const float mx = wave_max(fmaxf(fmaxf(v.x, v.y), fmaxf(v.z, v.w)));
        v.x = __builtin_amdgcn_exp2f(v.x - mx); v.y = __builtin_amdgcn_exp2f(v.y - mx); v.z = __builtin_amdgcn_exp2f(v.z - mx); v.w = __builtin_amdgcn_exp2f(v.w - mx);
        const float inv = 1.0f / wave_sum((v.x + v.y) + (v.z + v.w));
        *(LAS f32x4*)(Ssm + r * SP + 4 * lane) = v * inv; }
    __syncthreads();
    const int d = dq * 64 + (tid & 63), r0 = 2 * (tid >> 6);
    float o0 = 0.f, o1 = 0.f;
    const float* vp = CV + d;
    bf16_t* Osm = Q + (size_t)MS * D;
#pragma unroll 1
    for (int k0 = 0; k0 < 256; k0 += 32) {
        float vv[32];
#pragma unroll
        for (int j = 0; j < 32; ++j) vv[j] = vp[(size_t)(k0 + j) * 1024];
        asm volatile("" ::: "memory");
#pragma unroll
        for (int j = 0; j < 32; j += 4) { const f32x4 pa = *(const LAS f32x4*)(Ssm + r0 * SP + k0 + j), pb = *(const LAS f32x4*)(Ssm + (r0 + 1) * SP + k0 + j);
            o0 += (pa.x * vv[j] + pa.y * vv[j + 1]) + (pa.z * vv[j + 2] + pa.w * vv[j + 3]); o1 += (pb.x * vv[j] + pb.y * vv[j + 1]) + (pb.z * vv[j + 2] + pb.w * vv[j + 3]); }
    }
    Osm[(size_t)(MP + b * 16 + r0) * D + h * 256 + d] = (bf16_t)(cvt_pk_bf16(o0, 0.f) & 0xffffu);
    Osm[(size_t)(MP + b * 16 + r0 + 1) * D + h * 256 + d] = (bf16_t)(cvt_pk_bf16(o1, 0.f) & 0xffffu);
    __syncthreads();
}

__device__ __forceinline__ void final_norm(Frame& F) {
    int tid = threadIdx.x; asm volatile("" : "+v"(tid)); const int lane = tid & 63, wave = __builtin_amdgcn_readfirstlane(tid >> 6); (void)lane; (void)wave;
    const int gw = F.bid * 8 + wave, NGW = F.G * 8;
    const float* ssq = (const float*)(F.ws + WS_SSQ);
    const __attribute__((address_space(1))) f32x4* gp = (const __attribute__((address_space(1))) f32x4*)F.in[21] + 2 * lane; f32x4 gv[2][2];
#pragma unroll
    for (int h = 0; h < 2; ++h) { gv[h][0] = gp[128 * h]; gv[h][1] = gp[128 * h + 1]; }
    for (int m = gw; m < MT; m += NGW) {
        const float rs = row_rstd(ssq, m);
        __attribute__((address_space(1))) f32x4* yr = (__attribute__((address_space(1))) f32x4*)(F.out + (size_t)m * D) + 2 * lane;
        const __attribute__((address_space(1))) u32x4* xr = (const __attribute__((address_space(1))) u32x4*)((const bf16_t*)(F.ws + WS_XB) + (size_t)m * D) + lane;
        const u32x4 o0 = xr[0], o1 = xr[64];
        yr[0] = (f32x4){bf_lo(o0.x), bf_hi(o0.x), bf_lo(o0.y), bf_hi(o0.y)} * rs * gv[0][0]; yr[1] = (f32x4){bf_lo(o0.z), bf_hi(o0.z), bf_lo(o0.w), bf_hi(o0.w)} * rs * gv[0][1];
        yr[128] = (f32x4){bf_lo(o1.x), bf_hi(o1.x), bf_lo(o1.y), bf_hi(o1.y)} * rs * gv[1][0]; yr[129] = (f32x4){bf_lo(o1.z), bf_hi(o1.z), bf_lo(o1.w), bf_hi(o1.w)} * rs * gv[1][1];
    }
}

__global__ void __launch_bounds__(512, 2) fwd_kernel(Args args) {
    extern __shared__ __attribute__((aligned(16))) unsigned char lds_raw[];
    cg::grid_group grid = cg::this_grid();
    Frame F;
    F.lds = (LAS unsigned char*)lds_raw;
    F.G = gridDim.x; F.bid = blockIdx.x; F.in = args.in; F.out = args.out; F.ws = args.ws;
    unsigned char* ws = args.ws;
    float* ssq = (float*)(ws + WS_SSQ);
    bf16_t* XB = (bf16_t*)(ws + WS_XB); bf16_t* R1 = (bf16_t*)(ws + WS_R1); bf16_t* R2 = (bf16_t*)(ws + WS_R2);

    volatile LAS unsigned* bst = (volatile LAS unsigned*)(F.lds + RING_BYTES + 512);
    if (threadIdx.x < 2) bst[threadIdx.x] = 0u;
    __syncthreads();
    const XcdBarrier bar = xcd_barrier_post((unsigned*)ws, bst);

    prologue(F);
    if (args.ws == nullptr) grid.sync();
    xcd_barrier(bar);

    {
        pg8::Gemm g{(const bf16_t*)(ws + WS_MEMB), (const bf16_t*)(ws + WS_WKV), 1024, 1024, 1024, 0};
        pg8::StaticOrder S; S.init(2048, 4096, F.G, F.G - 1 - F.bid);
        EpiKV E{F.out + O_MK, F.out + O_MV, (bf16_t*)(ws + WS_KB), (bf16_t*)(ws + WS_VT), (const float*)(ws + WS_RSM)};
        pg8::gemm_phase<EpiKV, pg8::StaticOrder>(F.lds, g, S, E);
    }

    for (int step = 0; step < 20; ++step) {
        const int l = step / 10, s10 = step % 10, s = s10 < 8 ? s10 : s10 + 1;
        unsigned char* ws = args.ws; float* outp = args.out; asm volatile("" : "+s"(ws), "+s"(outp));
        F.ws = ws; F.out = outp;
        float* ssq = (float*)(ws + WS_SSQ);
        bf16_t* XB = (bf16_t*)(ws + WS_XB); bf16_t* R1 = (bf16_t*)(ws + WS_R1); bf16_t* R2 = (bf16_t*)(ws + WS_R2);
        unsigned char* wl = ws + WS_W + (size_t)l * W_L;
        int two = 2; asm volatile("" : "+s"(two));
        const bool sgfirst = ((F.bid >> 3) & 1) != 0;
        if (s == 0 || s == 9) {
            pg8::Gemm g{XB, (const bf16_t*)(wl + (s == 0 ? W_1 : W_1B)), 1024, 1024, 1024, 0};
            pg8::StaticOrder S; S.init(MP, 2 * FF, F.G, F.bid);
            EpiSwiglu E{R1, ssq};
            SgArgs sa{XB, 1024, g.Bt, 1024, 1024, ssq, R1, FF, nullptr, nullptr, nullptr, 0.f};
            for (int pass = 0; pass < two; ++pass) {
                if ((pass == 0) == sgfirst) sgemm_phase<0>(F.lds, sa, 8 * 88, F.bid, F.G);
                if (pass == 0) pg8::gemm_phase<EpiSwiglu, pg8::StaticOrder>(F.lds, g, S, E);
            }
        } else if (s == 1 || s == 4 || s == 7 || s == 10) {
            pg8::Gemm g; float scale;
            if (s == 1 || s == 10) { g = pg8::Gemm{R1, (const bf16_t*)(wl + (s == 1 ? W_2 : W_2B)), FF, FF, FF, 0}; scale = 0.5f; }
            else if (s == 4) { g = pg8::Gemm{R2, (const bf16_t*)(wl + W_O2), 1024, 1024, 1024, 0}; scale = 1.0f; }
            else { g = pg8::Gemm{R1, (const bf16_t*)(ws + WS_VW) + (size_t)l * 8 * 1024 * 1024, 1024, 1024, 1024, 3}; scale = 1.0f; }
            pg8::StaticOrder S; S.init(MP, 1024, F.G, F.bid);
            EpiResid E{XB, ssq, scale};
            SgArgs sa{g.A + (s == 7 ? MS * D : 0), g.lda, s == 7 ? (const bf16_t*)(wl + W_O) : g.Bt, g.ldb, g.K, nullptr, nullptr, 0, F.out, XB, ssq, scale};
            sgemm_phase<2>(F.lds, sa, 8 * 16, F.G - 1 - F.bid, F.G);
            pg8::gemm_phase<EpiResid, pg8::StaticOrder>(F.lds, g, S, E);
        } else if (s == 2 || s == 5) {
            pg8::Gemm g; pg8::StaticOrder S; EpiScale E;
            if (s == 2) { g = pg8::Gemm{XB, (const bf16_t*)(wl + W_M), 1024, 1024, 1024, 0}; S.init(MP, DIN, F.G, F.bid); E = EpiScale{R1, DIN, ssq}; }
            else { g = pg8::Gemm{XB, (const bf16_t*)(wl + W_Q), 1024, 1024, 1024, 0}; S.init(MP, 1024, F.G, F.bid); E = EpiScale{R1, 1024, ssq}; }
            if (s == 5) sgemm_phase<1>(F.lds, sa_dummy(XB, g.Bt, ssq, R1, 1024), 8 * 16, F.G - 1 - F.bid, F.G);
            else sgemm_phase<1>(F.lds, sa_dummy(XB, g.Bt, ssq, R1, DIN), 8 * 32, sgfirst ? ((F.bid >> 4) * 8 + (F.bid & 7)) : 8 * 32, F.G / 2);
            const int nsub = (s == 5 && l == 0) ? two : 1;
            for (int sub = 0; sub < nsub; ++sub) {
                if (sub == 1) {
                    g = pg8::Gemm{(const bf16_t*)(wl + W_O), (const bf16_t*)(ws + WS_VT), 1024, 1024, 256, 4};
                    S.init(16 * 1024, 1024, F.G, F.G - 1 - F.bid); E = EpiScale{(bf16_t*)(ws + WS_VW), 1024, nullptr}; }
                pg8::gemm_phase<EpiScale, pg8::StaticOrder>(F.lds, g, S, E);
            }
        } else if (s == 3) {
            mixer_phase(F, l);
        } else {
            pg8::Gemm g{R1, (const bf16_t*)(ws + WS_KB) + (size_t)l * 2048 * 1024, 1024, 1024, 256, 1};
            pg8::StaticOrder S; S.init(MP, 1024, F.G, F.bid);
            EpiSoftmax E{R1};
            for (int pass = 0; pass < two; ++pass) {
                if ((pass == 0) == sgfirst) { for (int pr = F.G - 1 - F.bid; pr < 256; pr += F.G) sample_attn(F, l, pr); }
                if (pass == 0) pg8::gemm_phase<EpiSoftmax, pg8::StaticOrder>(F.lds, g, S, E);
            }
        }
        xcd_barrier(bar);
    }
    final_norm(F);
}

extern "C" void kernel_launch(void* const* d_in, const int* in_sizes, int n_in, void* d_out, int out_size, void* d_ws, size_t ws_size, hipStream_t stream) {
    static int grid = 0;
    if (grid == 0) {
        if (n_in != 22 || (size_t)out_size != O_END || ws_size < WS_END) { fprintf(stderr, "kernel_launch: unexpected sizes n_in %d out %d ws %zu (need %zu)\n", n_in, out_size, ws_size, (size_t)WS_END); grid = -1; return; }
        int dev = 0, cus = 0, per_cu = 0;
        if (hipGetDevice(&dev) != hipSuccess || hipDeviceGetAttribute(&cus, hipDeviceAttributeMultiprocessorCount, dev) != hipSuccess) { grid = -1; return; }
        if (hipFuncSetAttribute((const void*)fwd_kernel, hipFuncAttributeMaxDynamicSharedMemorySize, LDS_BYTES) != hipSuccess) { fprintf(stderr, "kernel_launch: hipFuncSetAttribute failed\n"); grid = -1; return; }
        if (hipOccupancyMaxActiveBlocksPerMultiprocessor(&per_cu, (const void*)fwd_kernel, 512, LDS_BYTES) != hipSuccess || per_cu < 1) { fprintf(stderr, "kernel_launch: occupancy query says %d\n", per_cu); per_cu = 1; }
        (void)hipGetLastError();
        grid = cus * 1;
    }
    if (grid < 0) return;
    if (hipMemsetAsync(d_ws, 0, 65536, stream) != hipSuccess) { fprintf(stderr, "kernel_launch: hipMemsetAsync failed\n"); return; }
    Args a{};
    for (int i = 0; i < 22; ++i) a.in[i] = (const float*)d_in[i];
    a.out = (float*)d_out; a.ws = (unsigned char*)d_ws;
    void* kargs[] = {&a};
    hipError_t e = hipLaunchCooperativeKernel((const void*)fwd_kernel, dim3(grid), dim3(512), kargs, LDS_BYTES, stream);
    if (e != hipSuccess) fprintf(stderr, "kernel_launch: cooperative launch failed: %s (grid %d)\n", hipGetErrorString(e), grid);
}
```
